# Optimizing an MI355X kernel written in HIP

```python
import jax, jax.numpy as jnp
from jax import lax
import numpy as np

D_MODEL = 1024
BATCH = 32
SEQ = 2048
DEPTH = 1

HEAD_DIM = 64
N_HEADS = D_MODEL // HEAD_DIM
N_HEADS_A = N_HEADS // 2
N_HEADS_B = N_HEADS - N_HEADS_A
WIDTH_A = N_HEADS_A * HEAD_DIM
WIDTH_B = N_HEADS_B * HEAD_DIM
DILATED_PATTERNS = ((128, 1), (512, 4), (2048, 16))
Q_BLOCK = 128
ROT_DIM = HEAD_DIM // 4
ROPE_THETA = 500000.0
D_FF = ((8 * D_MODEL // 3 + 63) // 64) * 64
N_MOD = 9
EPS = 1e-6
ATTN_SCALE = HEAD_DIM ** -0.5
NEG = -1e30
COL_SIZES = (WIDTH_A, WIDTH_A, WIDTH_A, WIDTH_B, WIDTH_B, WIDTH_B, N_HEADS_B)
COL_OFFSETS = tuple(int(o) for o in np.cumsum(COL_SIZES)[:-1])
IN_COLS = int(sum(COL_SIZES))

kernel_name = 'hybrid_dilated_fox_macaron_block'


def rmsnorm(x, g):
    xf = x.astype(jnp.float32)
    y = xf * lax.rsqrt(jnp.mean(xf * xf, axis=-1, keepdims=True) + EPS)
    return (y * g.astype(jnp.float32)).astype(x.dtype)


def partial_rotary(t, positions):
    inv_freq = ROPE_THETA ** (-jnp.arange(0, ROT_DIM, 2, dtype=jnp.float32) / ROT_DIM)
    ang = positions.astype(jnp.float32)[:, None, :, None] * inv_freq
    cos, sin = jnp.cos(ang), jnp.sin(ang)
    tf = t.astype(jnp.float32)
    x1 = tf[..., :ROT_DIM // 2]
    x2 = tf[..., ROT_DIM // 2:ROT_DIM]
    rot = jnp.concatenate([x1 * cos - x2 * sin, x2 * cos + x1 * sin, tf[..., ROT_DIM:]], axis=-1)
    return rot.astype(t.dtype)


def swiglu(h, w_gate, w_up, w_down):
    return (jax.nn.silu(h @ w_gate) * (h @ w_up)) @ w_down


def banded_causal_attention(q, k, v, w):
    L = q.shape[-2]
    lead = q.shape[:-2]
    nb = -(-L // Q_BLOCK)
    Lp = nb * Q_BLOCK
    pad = [(0, 0)] * (q.ndim - 2)
    qp = jnp.pad(q, pad + [(0, Lp - L), (0, 0)])
    kp = jnp.pad(k, pad + [(w, Lp - L), (0, 0)])
    vp = jnp.pad(v, pad + [(w, Lp - L), (0, 0)])
    span = Q_BLOCK + w
    q_blk = qp.reshape(*lead, nb, Q_BLOCK, HEAD_DIM)
    idx = jnp.arange(nb)[:, None] * Q_BLOCK + jnp.arange(span)[None, :]
    k_blk = jnp.take(kp, idx, axis=-2)
    v_blk = jnp.take(vp, idx, axis=-2)
    s = jnp.einsum('...nqd,...nkd->...nqk', q_blk, k_blk,
                   preferred_element_type=jnp.float32) * ATTN_SCALE
    dist = jnp.arange(Q_BLOCK)[:, None] + w - jnp.arange(span)[None, :]
    key_pos = idx - w
    valid = ((dist >= 0) & (dist <= w))[None] & (key_pos >= 0)[:, None, :]
    s = jnp.where(valid, s, NEG)
    lse = jax.nn.logsumexp(s, axis=-1)
    p = jnp.exp(s - lse[..., None])
    o = jnp.einsum('...nqk,...nkd->...nqd', p.astype(v.dtype), v_blk)
    o = o.reshape(*lead, Lp, HEAD_DIM)[..., :L, :]
    lse = lse.reshape(*lead, Lp)[..., :L]
    return o, lse


def dilated_mixture_attention(q, k, v):
    B, H, S, hd = q.shape
    outs, lses = [], []
    for window, d in DILATED_PATTERNS:
        w_sub = window // d
        to_cls = lambda t: t.reshape(B, H, S // d, d, hd).swapaxes(2, 3)
        o, lse = banded_causal_attention(to_cls(q), to_cls(k), to_cls(v), w_sub)
        outs.append(o.swapaxes(2, 3).reshape(B, H, S, hd))
        lses.append(lse.swapaxes(2, 3).reshape(B, H, S))
    alpha = jax.nn.softmax(jnp.stack(lses, axis=0), axis=0)
    return jnp.einsum('pbhs,pbhsd->bhsd', alpha.astype(q.dtype), jnp.stack(outs, axis=0))


def forgetting_attention(q, k, v, f_logit):
    S = q.shape[2]
    log_f = jax.nn.log_sigmoid(f_logit.astype(jnp.float32)).transpose(0, 2, 1)
    F = lax.cumsum(log_f, axis=2)
    outs = []
    for i in range(S // Q_BLOCK):
        lo, hi = i * Q_BLOCK, (i + 1) * Q_BLOCK
        s = jnp.einsum('bhqd,bhkd->bhqk', q[:, :, lo:hi], k[:, :, :hi],
                       preferred_element_type=jnp.float32) * ATTN_SCALE
        s = s + F[:, :, lo:hi, None] - F[:, :, None, :hi]
        causal = (lo + jnp.arange(Q_BLOCK))[:, None] >= jnp.arange(hi)[None, :]
        p = jax.nn.softmax(jnp.where(causal, s, NEG), axis=-1)
        outs.append(jnp.einsum('bhqk,bhkd->bhqd', p.astype(v.dtype), v[:, :, :hi]))
    return jnp.concatenate(outs, axis=2)


def hybrid_mixer(h, positions, w_in, b_forget, g_out_a, g_out_b, w_out):
    B, S, _ = h.shape
    proj = h @ w_in
    qa, ka, va, qb, kb, vb, f_logit = jnp.split(proj, COL_OFFSETS, axis=-1)
    heads = lambda t, n: t.reshape(B, S, n, HEAD_DIM).transpose(0, 2, 1, 3)
    qa = partial_rotary(heads(qa, N_HEADS_A), positions)
    ka = partial_rotary(heads(ka, N_HEADS_A), positions)
    out_a = dilated_mixture_attention(qa, ka, heads(va, N_HEADS_A))
    out_b = forgetting_attention(heads(qb, N_HEADS_B), heads(kb, N_HEADS_B), heads(vb, N_HEADS_B),
                                 f_logit + b_forget)
    flat = lambda t: t.transpose(0, 2, 1, 3).reshape(B, S, -1)
    merged = jnp.concatenate([rmsnorm(flat(out_a), g_out_a), rmsnorm(flat(out_b), g_out_b)], axis=-1)
    return merged @ w_out


def setup_inputs(seed: int = 0) -> dict:
    key = jax.random.key(seed)
    ks = jax.random.split(key, 24)
    nrm = lambda k, shape, s: jax.random.normal(k, shape, jnp.float32) * s
    gain = lambda k, n: 1.0 + 0.05 * jax.random.normal(k, (DEPTH, n), jnp.float32)
    return {
        'x': nrm(ks[0], (BATCH, SEQ, D_MODEL), 1.0),
        'c': nrm(ks[1], (BATCH, D_MODEL), 1.0),
        'positions': jnp.broadcast_to(jnp.arange(SEQ, dtype=jnp.int32)[None, :], (BATCH, SEQ)),
        'w_ada': nrm(ks[2], (DEPTH, D_MODEL, N_MOD * D_MODEL), 0.01),
        'b_ada': nrm(ks[3], (DEPTH, N_MOD * D_MODEL), 0.02),
        'g_pre_ff1': gain(ks[4], D_MODEL),
        'g_post_ff1': gain(ks[5], D_MODEL),
        'w_ff1_gate': nrm(ks[6], (DEPTH, D_MODEL, D_FF), D_MODEL ** -0.5),
        'w_ff1_up': nrm(ks[7], (DEPTH, D_MODEL, D_FF), D_MODEL ** -0.5),
        'w_ff1_down': nrm(ks[8], (DEPTH, D_FF, D_MODEL), D_FF ** -0.5),
        'g_pre_mix': gain(ks[9], D_MODEL),
        'g_post_mix': gain(ks[10], D_MODEL),
        'w_in': nrm(ks[11], (DEPTH, D_MODEL, IN_COLS), D_MODEL ** -0.5),
        'b_forget': jax.random.uniform(ks[12], (DEPTH, N_HEADS_B), jnp.float32, 1.0, 4.0),
        'g_out_a': gain(ks[13], WIDTH_A),
        'g_out_b': gain(ks[14], WIDTH_B),
        'w_out': nrm(ks[15], (DEPTH, D_MODEL, D_MODEL), D_MODEL ** -0.5),
        'g_pre_ff2': gain(ks[16], D_MODEL),
        'g_post_ff2': gain(ks[17], D_MODEL),
        'w_ff2_gate': nrm(ks[18], (DEPTH, D_MODEL, D_FF), D_MODEL ** -0.5),
        'w_ff2_up': nrm(ks[19], (DEPTH, D_MODEL, D_FF), D_MODEL ** -0.5),
        'w_ff2_down': nrm(ks[20], (DEPTH, D_FF, D_MODEL), D_FF ** -0.5),
    }


def reference(x, c, positions, w_ada, b_ada, g_pre_ff1, g_post_ff1, w_ff1_gate, w_ff1_up, w_ff1_down,
              g_pre_mix, g_post_mix, w_in, b_forget, g_out_a, g_out_b, w_out,
              g_pre_ff2, g_post_ff2, w_ff2_gate, w_ff2_up, w_ff2_down):
    B = x.shape[0]
    silu_c = jax.nn.silu(c)
    for l in range(DEPTH):
        mod = (silu_c @ w_ada[l] + b_ada[l]).reshape(B, N_MOD, D_MODEL)
        m = lambda i: mod[:, i][:, None, :]
        h = rmsnorm(x, g_pre_ff1[l]) * (1.0 + m(1)) + m(0)
        y = rmsnorm(swiglu(h, w_ff1_gate[l], w_ff1_up[l], w_ff1_down[l]), g_post_ff1[l])
        x = x + 0.5 * m(2) * y
        h = rmsnorm(x, g_pre_mix[l]) * (1.0 + m(4)) + m(3)
        y = rmsnorm(hybrid_mixer(h, positions, w_in[l], b_forget[l], g_out_a[l], g_out_b[l], w_out[l]),
                    g_post_mix[l])
        x = x + m(5) * y
        h = rmsnorm(x, g_pre_ff2[l]) * (1.0 + m(7)) + m(6)
        y = rmsnorm(swiglu(h, w_ff2_gate[l], w_ff2_up[l], w_ff2_down[l]), g_post_ff2[l])
        x = x + 0.5 * m(8) * y
    return x
```

```cpp
#include <hip/hip_runtime.h>
#include <hip/hip_cooperative_groups.h>
#include <cstdio>
#include <cstdint>
namespace cg = cooperative_groups;
namespace pg8 {
#define PG8_LAS __attribute__((address_space(3)))
typedef unsigned short bf16_t;
typedef short bf16x8 __attribute__((ext_vector_type(8)));
typedef float f32x4 __attribute__((ext_vector_type(4)));
typedef unsigned u32x4 __attribute__((ext_vector_type(4)));
constexpr int BM = 256, BK = 64, HALF = 128, HTB = HALF * BK * 2  , STAGE_BYTES = 8 * HTB, NXCD = 8, WGM = 4;

__host__ __device__ __forceinline__ int lds_byte(int r, int c) { const int st = (r >> 4) * 2 + (c >> 5), rr = r & 15, cc = c & 31, ob = rr * 64 + cc * 2; return st * 1024 + (ob ^ (((ob >> 9) & 1) << 5)); }
__host__ __device__ __forceinline__ void stage_rc(int b, int& R, int& C) { const int st = b / 1024, sb = b % 1024, swz = sb ^ (((sb >> 9) & 1) << 5); R = (st >> 1) * 16 + swz / 64; C = (st & 1) * 32 + (swz % 64) / 2; }
__host__ __device__ __forceinline__ int perm32(int rho) { const int n = rho >> 4, i = rho & 15; return 8 * (i >> 2) + 4 * n + (i & 3); }

struct Unit { int pm, pn; };
struct Gemm { const bf16_t* A; const bf16_t* Bt; int M, N, K; };

struct StaticOrder {
    int nM, nN, nwg, G, c;
    __host__ __device__ void init(int M, int N, int G_, int c_) { nM = M / BM; nN = N / BM; nwg = nM * nN; G = G_; c = c_; }
    __host__ __device__ bool next(int i, Unit& u) const {
        const long L = (long)i * G + c; if (L >= nwg) return false;
        int wgid = (int)L; { const int q = nwg / NXCD, r = nwg % NXCD, xcd = wgid % NXCD, off = wgid / NXCD; wgid = (xcd < r ? xcd * (q + 1) : r * (q + 1) + (xcd - r) * q) + off; }
        const int nig = WGM * nN, gid = wgid / nig, fm = gid * WGM, gsz = (nM - fm) < WGM ? (nM - fm) : WGM;
        u.pm = fm + ((wgid % nig) % gsz); u.pn = (wgid % nig) / gsz; return true;
    }
    __device__ __forceinline__ void a_ready(const Unit&) const {}
    __device__ __forceinline__ void done(const Unit&) const {}
};


__device__ __forceinline__ unsigned cvt_pk_bf16(float lo, float hi) { unsigned r; asm volatile("v_cvt_pk_bf16_f32 %0, %1, %2" : "=v"(r) : "v"(lo), "v"(hi)); return r; }
typedef unsigned u32x4 __attribute__((ext_vector_type(4)));

struct EpiPlain {
    static constexpr bool PERM = true, AFTER_DRAIN = false;
    bf16_t* O; int ldc;
    __device__ __forceinline__ void operator()(const f32x4 (&acc)[2][2][4][2], const Unit& u, int wr, int wc, int fr, int fq) const {
        const int row0 = u.pm * BM + wr * 64 + fr; const int col0 = u.pn * BM + wc * 32 + 8 * fq;
#pragma unroll
        for (int ai = 0; ai < 2; ++ai)
#pragma unroll
            for (int m = 0; m < 4; ++m) { bf16_t* rowp = O + (size_t)(row0 + ai * HALF + m * 16) * ldc + col0;
#pragma unroll
                for (int bj = 0; bj < 2; ++bj) { const f32x4 v0 = acc[ai][bj][m][0], v1 = acc[ai][bj][m][1];
                    u32x4 w; w.x = cvt_pk_bf16(v0[0], v0[1]); w.y = cvt_pk_bf16(v0[2], v0[3]); w.z = cvt_pk_bf16(v1[0], v1[1]); w.w = cvt_pk_bf16(v1[2], v1[3]);
                    *(u32x4*)(rowp + bj * HALF) = w; } }
    }
};
__device__ __forceinline__ float silu_mul(float g, float u) { return g * u * __builtin_amdgcn_rcpf(1.0f + __builtin_amdgcn_exp2f(-1.4426950408889634f * g)); }
struct EpiSwiglu {
    static constexpr bool PERM = true, AFTER_DRAIN = false;
    bf16_t* O; int ldc;
    __device__ __forceinline__ void operator()(const f32x4 (&acc)[2][2][4][2], const Unit& u, int wr, int wc, int fr, int fq) const {
        const int row0 = u.pm * BM + wr * 64 + fr; const int col0 = u.pn * HALF + wc * 32 + 8 * fq;
#pragma unroll
        for (int ai = 0; ai < 2; ++ai)
#pragma unroll
            for (int m = 0; m < 4; ++m) { bf16_t* rowp = O + (size_t)(row0 + ai * HALF + m * 16) * ldc + col0;
                const f32x4 g0 = acc[ai][0][m][0], g1 = acc[ai][0][m][1], u0 = acc[ai][1][m][0], u1 = acc[ai][1][m][1];
                u32x4 w;
                w.x = cvt_pk_bf16(silu_mul(g0[0], u0[0]), silu_mul(g0[1], u0[1])); w.y = cvt_pk_bf16(silu_mul(g0[2], u0[2]), silu_mul(g0[3], u0[3]));
                w.z = cvt_pk_bf16(silu_mul(g1[0], u1[0]), silu_mul(g1[1], u1[1])); w.w = cvt_pk_bf16(silu_mul(g1[2], u1[2]), silu_mul(g1[3], u1[3]));
                *(u32x4*)rowp = w; }
    }
};
struct EpiQKV {
    static constexpr bool PERM = true, AFTER_DRAIN = false;
    bf16_t* O; size_t stride; const float* rope;
    __device__ __forceinline__ void operator()(const f32x4 (&acc)[2][2][4][2], const Unit& u, int wr, int wc, int fr, int fq) const {
        const int t = u.pn >> 1; const int colt = (u.pn & 1) * BM;
        bf16_t* base = O + (size_t)t * stride;
        const int row0 = u.pm * BM + wr * 64 + fr; const int col0 = colt + wc * 32 + 8 * fq;
        const bool rot = (t < 2) && ((wc & 1) == 0);
        const float sgn = (fq == 0) ? -1.f : 1.f;
        const float qsc = (t == 3) ? 0.18033688011112042f : 1.0f;
#pragma unroll
        for (int ai = 0; ai < 2; ++ai)
#pragma unroll
            for (int m = 0; m < 4; ++m) { const int row = row0 + ai * HALF + m * 16; bf16_t* rowp = base + (size_t)row * 512 + col0;
                f32x4 c0 = {1.f, 1.f, 1.f, 1.f}, c1 = c0, s0 = {0.f, 0.f, 0.f, 0.f}, s1 = s0;
                if (rot && fq < 2) { const f32x4* rp = (const f32x4*)(rope + (size_t)row * 16); c0 = rp[0]; c1 = rp[1]; s0 = rp[2] * sgn; s1 = rp[3] * sgn; }
#pragma unroll
                for (int bj = 0; bj < 2; ++bj) { f32x4 v0 = acc[ai][bj][m][0], v1 = acc[ai][bj][m][1];
                    if (rot) {
                        f32x4 p0, p1;
#pragma unroll
                        for (int j = 0; j < 4; ++j) { p0[j] = __shfl_xor(v0[j], 16); p1[j] = __shfl_xor(v1[j], 16); }
                        v0 = v0 * c0 + p0 * s0; v1 = v1 * c1 + p1 * s1;
                    }
                    v0 = v0 * qsc; v1 = v1 * qsc;
                    u32x4 w; w.x = cvt_pk_bf16(v0[0], v0[1]); w.y = cvt_pk_bf16(v0[2], v0[3]); w.z = cvt_pk_bf16(v1[0], v1[1]); w.w = cvt_pk_bf16(v1[2], v1[3]);
                    *(u32x4*)(rowp + bj * HALF) = w; } }
    }
};

template <class Epi, class Sched, bool ALIGN_EPI = false, bool SP2 = false>
__device__ __forceinline__ void gemm_phase(PG8_LAS unsigned char* lds, const Gemm g, const Sched& S, const Epi& E) {
    int tid_o = threadIdx.x; asm volatile("" : "+v"(tid_o));
    const int tid = tid_o, wid = __builtin_amdgcn_readfirstlane(tid >> 6), lane = tid & 63, wr = wid >> 2, wc = wid & 3, fr = lane & 15, fq = lane >> 4;
    const int K = g.K, nt = K / BK;
    unsigned voffA[2], voffB[2];
#pragma unroll
    for (int i = 0; i < 2; ++i) { int R, C; stage_rc(tid * 16 + i * 8192, R, C); const int Rb = Epi::PERM ? ((R & ~31) + perm32(R & 31)) : R;
        voffA[i] = (unsigned)(R * K + C) * 2u; voffB[i] = (unsigned)(Rb * K + C) * 2u; }
    const size_t kstep = (size_t)(BK * 2);
    const size_t hstep = (size_t)HALF * K * 2;
    const size_t tstep = 2 * hstep;
    const unsigned ldsw = (unsigned)wid * 1024u;
    const int aoff = lds_byte(wr * 64 + fr, fq * 8), boff = lds_byte(wc * 32 + fr, fq * 8);
#define PG8_SA(b, h) (((b) * 2 + (h)) * HTB)
#define PG8_SB(b, h) ((4 + (b) * 2 + (h)) * HTB)
#define PG8_STAGE(bufoff, gbase, voff) do { _Pragma("unroll") for (int _i = 0; _i < 2; ++_i) \
        __builtin_amdgcn_global_load_lds((const unsigned*)((const char*)(gbase) + (voff)[_i]), (PG8_LAS unsigned*)(lds + (bufoff) + ldsw + _i * 8192), 16, 0, 0); } while (0)
#define PG8_LDA(dst, b, h) do { _Pragma("unroll") for (int m = 0; m < 4; ++m) _Pragma("unroll") for (int k = 0; k < 2; ++k) dst[m][k] = *(const PG8_LAS bf16x8*)(lds + PG8_SA(b, h) + aoff + m * 2048 + k * 1024); } while (0)
#define PG8_LDB(dst, b, h) do { _Pragma("unroll") for (int n = 0; n < 2; ++n) _Pragma("unroll") for (int k = 0; k < 2; ++k) dst[n][k] = *(const PG8_LAS bf16x8*)(lds + PG8_SB(b, h) + boff + n * 2048 + k * 1024); } while (0)
#define PG8_MMA(ai, bj, At, Bt) do { __builtin_amdgcn_s_setprio(1); _Pragma("unroll") for (int m = 0; m < 4; ++m) _Pragma("unroll") for (int n = 0; n < 2; ++n) _Pragma("unroll") for (int k = 0; k < 2; ++k) \
        acc[ai][bj][m][n] = __builtin_amdgcn_mfma_f32_16x16x32_bf16(Bt[n][k], At[m][k], acc[ai][bj][m][n], 0, 0, 0); __builtin_amdgcn_s_setprio(0); } while (0)
#define PG8_WAIT_V(n) asm volatile("s_waitcnt vmcnt(" #n ")" ::: "memory")
#define PG8_WAIT_L(n) asm volatile("s_waitcnt lgkmcnt(" #n ")" ::: "memory")
#define PG8_BAR __builtin_amdgcn_s_barrier()
#define PG8_SCHED __builtin_amdgcn_sched_barrier(0)
    Unit cur, nxt; int ui = 0;
    if (!S.next(0, cur)) return;
    f32x4 acc[2][2][4][2];
#pragma unroll
    for (int a = 0; a < 2; ++a)
#pragma unroll
        for (int b = 0; b < 2; ++b)
#pragma unroll
            for (int m = 0; m < 4; ++m)
#pragma unroll
                for (int n = 0; n < 2; ++n) acc[a][b][m][n] = (f32x4){0.f, 0.f, 0.f, 0.f};
    bf16x8 At[4][2], B0[2][2], B1[2][2];
    const char* cA = (const char*)g.A + (size_t)cur.pm * tstep; const char* cB = (const char*)g.Bt + (size_t)cur.pn * tstep;
    S.a_ready(cur);
    if constexpr (SP2) {
        PG8_STAGE(PG8_SB(0, 0), cB, voffB); PG8_STAGE(PG8_SB(0, 1), cB + hstep, voffB); PG8_STAGE(PG8_SA(0, 0), cA, voffA); PG8_STAGE(PG8_SA(0, 1), cA + hstep, voffA);
        if (wr == 1) PG8_BAR;
        PG8_WAIT_V(2); PG8_BAR;
        PG8_STAGE(PG8_SB(1, 0), cB + kstep, voffB); PG8_STAGE(PG8_SA(1, 0), cA + kstep, voffA); PG8_STAGE(PG8_SB(1, 1), cB + hstep + kstep, voffB);
        PG8_WAIT_V(6); PG8_BAR;
    } else {
        PG8_STAGE(PG8_SB(0, 0), cB, voffB); PG8_STAGE(PG8_SA(0, 0), cA, voffA); PG8_STAGE(PG8_SB(0, 1), cB + hstep, voffB); PG8_STAGE(PG8_SA(0, 1), cA + hstep, voffA);
        if (wr == 1) PG8_BAR;
        PG8_WAIT_V(4); PG8_BAR;
        PG8_STAGE(PG8_SB(1, 0), cB + kstep, voffB); PG8_STAGE(PG8_SA(1, 0), cA + kstep, voffA); PG8_STAGE(PG8_SB(1, 1), cB + hstep + kstep, voffB);
        PG8_WAIT_V(6); PG8_BAR;
    }
    for (;;) {
        const bool has_next = S.next(ui + 1, nxt);
        const char* nA = has_next ? (const char*)g.A + (size_t)nxt.pm * tstep : cA; const char* nB = has_next ? (const char*)g.Bt + (size_t)nxt.pn * tstep : cB;
        for (int t = 0; t < nt; t += 2) {
            const bool last = (t == nt - 2);
            const char* a1 = cA + (size_t)(t + 1) * kstep;
            const char* a2 = last ? nA : cA + (size_t)(t + 2) * kstep; const char* b2 = last ? nB : cB + (size_t)(t + 2) * kstep;
            const char* a3 = a2 + kstep; const char* b3 = b2 + kstep;
            if (last && has_next) S.a_ready(nxt);
            if constexpr (SP2) {
            PG8_LDB(B0, 0, 0); PG8_LDB(B1, 0, 1); PG8_SCHED; PG8_LDA(At, 0, 0); PG8_STAGE(PG8_SA(1, 1), a1 + hstep, voffA);
            PG8_WAIT_V(8); PG8_WAIT_L(0); PG8_BAR; PG8_MMA(0, 0, At, B0); PG8_MMA(0, 1, At, B1); PG8_BAR; PG8_SCHED;
            PG8_LDA(At, 0, 1); PG8_STAGE(PG8_SB(0, 0), b2, voffB); PG8_STAGE(PG8_SB(0, 1), b2 + hstep, voffB); PG8_STAGE(PG8_SA(0, 0), a2, voffA);
            PG8_WAIT_V(8); PG8_WAIT_L(0); PG8_BAR; PG8_MMA(1, 0, At, B0); PG8_MMA(1, 1, At, B1); PG8_BAR; PG8_SCHED;
            PG8_LDB(B0, 1, 0); PG8_LDB(B1, 1, 1); PG8_SCHED; PG8_LDA(At, 1, 0); PG8_STAGE(PG8_SA(0, 1), a2 + hstep, voffA);
            PG8_WAIT_V(8); PG8_WAIT_L(0); PG8_BAR; PG8_MMA(0, 0, At, B0); PG8_MMA(0, 1, At, B1); PG8_BAR; PG8_SCHED;
            PG8_LDA(At, 1, 1); PG8_STAGE(PG8_SB(1, 0), b3, voffB); PG8_STAGE(PG8_SB(1, 1), b3 + hstep, voffB); PG8_STAGE(PG8_SA(1, 0), a3, voffA);
            PG8_WAIT_V(8); PG8_WAIT_L(0); PG8_BAR; PG8_MMA(1, 0, At, B0); PG8_MMA(1, 1, At, B1); PG8_BAR; PG8_SCHED;
            } else {
            PG8_LDB(B0, 0, 0); PG8_SCHED; PG8_LDA(At, 0, 0); PG8_STAGE(PG8_SA(1, 1), a1 + hstep, voffA);
            PG8_WAIT_L(8); PG8_BAR; PG8_WAIT_L(0); PG8_MMA(0, 0, At, B0); PG8_BAR; PG8_SCHED;
            PG8_LDB(B1, 0, 1); PG8_STAGE(PG8_SB(0, 0), b2, voffB);
            PG8_BAR; PG8_WAIT_L(0); PG8_MMA(0, 1, At, B1); PG8_BAR;
            PG8_LDA(At, 0, 1); PG8_STAGE(PG8_SA(0, 0), a2, voffA);
            PG8_BAR; PG8_WAIT_L(0); PG8_MMA(1, 0, At, B0); PG8_BAR; PG8_SCHED;
            PG8_STAGE(PG8_SB(0, 1), b2 + hstep, voffB);
            PG8_WAIT_V(6); PG8_BAR; PG8_MMA(1, 1, At, B1); PG8_BAR;
            PG8_LDB(B0, 1, 0); PG8_SCHED; PG8_LDA(At, 1, 0); PG8_STAGE(PG8_SA(0, 1), a2 + hstep, voffA);
            PG8_WAIT_L(8); PG8_BAR; PG8_WAIT_L(0); PG8_MMA(0, 0, At, B0); PG8_BAR; PG8_SCHED;
            PG8_LDB(B1, 1, 1); PG8_STAGE(PG8_SB(1, 0), b3, voffB);
            PG8_BAR; PG8_WAIT_L(0); PG8_MMA(0, 1, At, B1); PG8_BAR;
            PG8_LDA(At, 1, 1); PG8_STAGE(PG8_SA(1, 0), a3, voffA);
            PG8_BAR; PG8_WAIT_L(0); PG8_MMA(1, 0, At, B0); PG8_BAR; PG8_SCHED;
            PG8_STAGE(PG8_SB(1, 1), b3 + hstep, voffB);
            PG8_WAIT_V(6); PG8_BAR; PG8_MMA(1, 1, At, B1); PG8_BAR;
            }
        }
        if constexpr (ALIGN_EPI) { if (wr == 0) PG8_BAR; }
        if constexpr (!Epi::AFTER_DRAIN) { E(acc, cur, wr, wc, fr, fq); S.done(cur); }
        if (!has_next) break;
#pragma unroll
        for (int a = 0; a < 2; ++a)
#pragma unroll
            for (int b = 0; b < 2; ++b)
#pragma unroll
                for (int m = 0; m < 4; ++m)
#pragma unroll
                    for (int n = 0; n < 2; ++n) acc[a][b][m][n] = (f32x4){0.f, 0.f, 0.f, 0.f};
        cur = nxt; cA = nA; cB = nB; ++ui;
        if constexpr (ALIGN_EPI) { if (wr == 1) PG8_BAR; }
    }
    PG8_WAIT_V(0);
    if constexpr (!ALIGN_EPI) { if (wr == 0) PG8_BAR; }
    PG8_BAR;
    if constexpr (Epi::AFTER_DRAIN) { E.fused(acc, cur, wr, wc, fr, fq, lds, wid, lane); S.done(cur); }
#undef PG8_SA
#undef PG8_SB
#undef PG8_STAGE
#undef PG8_LDA
#undef PG8_LDB
#undef PG8_MMA
#undef PG8_WAIT_V
#undef PG8_WAIT_L
#undef PG8_BAR
#undef PG8_SCHED
}
}
#include <hip/hip_bf16.h>
#include <cmath>
namespace attn_body {
using bf16=__hip_bfloat16;
using bf16x8=__attribute__((ext_vector_type(8)))short;
using s16x4=__attribute__((ext_vector_type(4)))short;
using f32x16=__attribute__((ext_vector_type(16)))float;
using u32x4=__attribute__((ext_vector_type(4)))unsigned;
using f32x4_t=__attribute__((ext_vector_type(4)))float;
constexpr int BATCH=32,NHEAD=8,SEQ=2048,D=64,DM=512;
constexpr int NW=8,QBLK=32,QB=QBLK*NW,KVBLK=64,NQB=SEQ/QB;
constexpr int ATTN_PITCH=DM, ATTN_UNIT_ROWS=QB;
__device__ __forceinline__ int crow(int r,int hi){return (r&3)+8*(r>>2)+4*hi;}
#define SBAR() __builtin_amdgcn_sched_barrier(0)
__device__ __forceinline__ void cmask(f32x16&p0,f32x16&p1,int jb,int qrel,int hi){
  const float NEG=-INFINITY; int lim=qrel-64*jb-4*hi; asm volatile("":"+v"(lim));
  #pragma unroll
  for(int r=0;r<16;++r){const int c=(r&3)+8*(r>>2); if(c>lim)p0[r]=NEG; if(c+32>lim)p1[r]=NEG;}
}

constexpr int NSLOT=3, SLOTB=8192;
constexpr int LDS_K=0, LDS_V=NSLOT*SLOTB, LDS_WS=2*NSLOT*SLOTB, LDS_OST=LDS_WS+NW*64*4, LDS_KB=LDS_OST+NW*4096, LDS_BYTES=LDS_KB+SEQ*4;
constexpr float C2=0.125f*1.4426950408889634f;
__device__ __forceinline__ void glds16(const void*gsrc,unsigned lds_dst){unsigned keep;
  asm volatile("s_mov_b32 %0, m0\n\ts_mov_b32 m0, %2\n\ts_nop 0\n\tglobal_load_lds_dwordx4 %1, off\n\ts_mov_b32 m0, %0":"=&s"(keep):"v"(gsrc),"s"(lds_dst):"memory");}
__device__ __forceinline__ float max3f(float a,float b,float c){float r;asm("v_max3_f32 %0, %1, %2, %3":"=v"(r):"v"(a),"v"(b),"v"(c));return r;}
__device__ __forceinline__ float max2f(float a,float b){float r;asm("v_max_f32_e32 %0, %1, %2":"=v"(r):"v"(a),"v"(b));return r;}
__device__ __forceinline__ float fadd_s(float a,float b){float r;asm("v_add_f32_e32 %0, %1, %2":"=v"(r):"v"(a),"v"(b));return r;}
__device__ __forceinline__ float fsub_s(float a,float b){float r;asm("v_sub_f32_e32 %0, %1, %2":"=v"(r):"v"(a),"v"(b));return r;}
typedef float f32x2_t __attribute__((ext_vector_type(2))); typedef __bf16 bf16x2_t __attribute__((ext_vector_type(2)));
__device__ __forceinline__ unsigned cvtpk_s(float lo,float hi){f32x2_t v={lo,hi};bf16x2_t b=__builtin_convertvector(v,bf16x2_t);return __builtin_bit_cast(unsigned,b);}
#define WAIT_BAR(N) asm volatile("s_waitcnt vmcnt(" #N ") lgkmcnt(0)\n\ts_barrier":::"memory")

__device__ __forceinline__ void qkt(f32x16&p0,f32x16&p1,const char*Kslot,const bf16x8*qr,const f32x16&c0,const f32x16&c1,int r32,int hi){
  const char*kb=Kslot+hi*1024+r32*16;
  #pragma unroll
  for(int d0=0;d0<4;++d0){
    const bf16x8 b0=*reinterpret_cast<const bf16x8*>(kb+d0*2048);
    const bf16x8 b1=*reinterpret_cast<const bf16x8*>(kb+d0*2048+512);
    if(d0==0){p0=__builtin_amdgcn_mfma_f32_32x32x16_bf16(b0,qr[0],c0,0,0,0);p1=__builtin_amdgcn_mfma_f32_32x32x16_bf16(b1,qr[0],c1,0,0,0);}
    else{p0=__builtin_amdgcn_mfma_f32_32x32x16_bf16(b0,qr[d0],p0,0,0,0);p1=__builtin_amdgcn_mfma_f32_32x32x16_bf16(b1,qr[d0],p1,0,0,0);}}
}
typedef __attribute__((address_space(3))) const char* lds_cptr;
typedef short v4i16_t __attribute__((ext_vector_type(4)));
__device__ __forceinline__ void kload8(bf16x8*kf,lds_cptr kp){
  kf[0]=*(const __attribute__((address_space(3))) bf16x8*)(kp);      kf[1]=*(const __attribute__((address_space(3))) bf16x8*)(kp+512);
  kf[2]=*(const __attribute__((address_space(3))) bf16x8*)(kp+2048); kf[3]=*(const __attribute__((address_space(3))) bf16x8*)(kp+2560);
  kf[4]=*(const __attribute__((address_space(3))) bf16x8*)(kp+4096); kf[5]=*(const __attribute__((address_space(3))) bf16x8*)(kp+4608);
  kf[6]=*(const __attribute__((address_space(3))) bf16x8*)(kp+6144); kf[7]=*(const __attribute__((address_space(3))) bf16x8*)(kp+6656);
}
__device__ __forceinline__ void kload2(bf16x8*kf,lds_cptr kp,int j){ kf[2*j]=*(const __attribute__((address_space(3))) bf16x8*)(kp+j*2048); kf[2*j+1]=*(const __attribute__((address_space(3))) bf16x8*)(kp+j*2048+512); }
__device__ __forceinline__ s16x4 vtr(lds_cptr p){ return __builtin_bit_cast(s16x4,__builtin_amdgcn_ds_read_tr16_b64_v4i16((__attribute__((address_space(3))) v4i16_t*)p)); }
__device__ __forceinline__ float rowmax(const f32x16&p0,const f32x16&p1){
  float a=max3f(p0[0],p0[1],p1[0]),b=max3f(p0[2],p0[3],p1[1]);a=max3f(a,p1[2],p1[3]);
  #pragma unroll
  for(int r=4;r<16;r+=4){a=max3f(a,p0[r],p0[r+1]);b=max3f(b,p0[r+2],p0[r+3]);a=max3f(a,p1[r],p1[r+1]);b=max3f(b,p1[r+2],p1[r+3]);}
  const float m=max2f(a,b);
  auto rr=__builtin_amdgcn_permlane32_swap(__float_as_uint(m),__float_as_uint(m),false,false);
  return max2f(__uint_as_float(rr[0]),__uint_as_float(rr[1]));
}
__device__ __forceinline__ void pv(f32x16*o,int vb,bf16x8 pa0,bf16x8 pa1,bf16x8 pa2,bf16x8 pa3){
  #pragma unroll
  for(int d0=0;d0<2;++d0){s16x4 lo[4],hi[4];
    #pragma unroll
    for(int ks=0;ks<4;++ks){
      asm volatile("ds_read_b64_tr_b16 %0,%1 offset:%c2":"=&v"(lo[ks]):"v"(vb),"i"(d0*4096+ks*1024):"memory");
      asm volatile("ds_read_b64_tr_b16 %0,%1 offset:%c2":"=&v"(hi[ks]):"v"(vb),"i"(d0*4096+ks*1024+512):"memory");}
    asm volatile("s_waitcnt lgkmcnt(0)":::"memory");SBAR();
    #define PK(k) (bf16x8){lo[k][0],lo[k][1],lo[k][2],lo[k][3],hi[k][0],hi[k][1],hi[k][2],hi[k][3]}
    o[d0]=__builtin_amdgcn_mfma_f32_32x32x16_bf16(pa0,PK(0),o[d0],0,0,0);
    o[d0]=__builtin_amdgcn_mfma_f32_32x32x16_bf16(pa1,PK(1),o[d0],0,0,0);
    o[d0]=__builtin_amdgcn_mfma_f32_32x32x16_bf16(pa2,PK(2),o[d0],0,0,0);
    o[d0]=__builtin_amdgcn_mfma_f32_32x32x16_bf16(pa3,PK(3),o[d0],0,0,0);
    #undef PK
  }
}

#ifndef ATTN_STORE16
#define ATTN_STORE16(p,v) (*(u32x4*)(p)=(v))
#endif
template<int THRL> __device__ __forceinline__ void attn_unit(int b,int h,int qb,const bf16*Q,const bf16*__restrict__ K,const bf16*__restrict__ V,bf16*O,char*shm){
  int tid_o=threadIdx.x; asm volatile("":"+v"(tid_o));
  const int tid=tid_o,lane=tid&63,r32=lane&31,hi=lane>>5; const int wid=__builtin_amdgcn_readfirstlane(tid>>6);
  const long rowbase=(long)b*SEQ; const int q0=qb*QB;
  const bf16*Qw=Q+(rowbase+q0+wid*QBLK)*DM+h*D;
  const bf16*Kh=K+rowbase*DM+h*D,*Vh=V+rowbase*DM+h*D;
  const unsigned lds0=(unsigned)(uintptr_t)shm;
  float*wsf=(float*)(shm+LDS_WS)+wid*64;
  const bf16*ksrc=Kh+(long)(lane+q0+QB-KVBLK)*DM+wid*8;
  const bf16*vsrc=Vh+(long)(16*(wid&3)+(lane>>2)+q0+QB-KVBLK)*DM+(wid>>2)*32+(lane&3)*8;
  const unsigned kdst=lds0+LDS_K+wid*1024, vdst=lds0+LDS_V+wid*1024;
  #define DMA_K(t,slot) glds16(ksrc-(long)(t)*KVBLK*DM,(unsigned)__builtin_amdgcn_readfirstlane(kdst+(slot)))
  #define DMA_V(t,slot) glds16(vsrc-(long)(t)*KVBLK*DM,(unsigned)__builtin_amdgcn_readfirstlane(vdst+(slot)))
  const int vb0=(int)(lds0+LDS_V)+((lane>>4)&1)*32+(lane&3)*8+(4*hi+((lane&15)>>2))*64;
  const char*Kbase=shm+LDS_K; bf16x8 kf[8];
  const lds_cptr shm3=(lds_cptr)shm; const lds_cptr kp0=shm3+LDS_K+hi*1024+r32*16; const lds_cptr vp0=shm3+LDS_V+((lane>>4)&1)*32+(lane&3)*8+(4*hi+((lane&15)>>2))*64;
  const int NT=(q0+QB)/KVBLK;
  DMA_K(0,0);DMA_V(0,0);DMA_K(1,SLOTB);
  bf16x8 qr[4];
  #pragma unroll
  for(int d0=0;d0<4;++d0)qr[d0]=*reinterpret_cast<const bf16x8*>(&Qw[(long)r32*DM+d0*16+hi*8]);
  float mhat=0.f,l_reg=0.f;f32x16 o[2];o[0]=f32x16{};o[1]=f32x16{};  typedef __attribute__((address_space(3))) const f32x4_t* lds_f4ptr; const lds_f4ptr kbl4=(lds_f4ptr)(shm3+LDS_KB)+hi+(q0+QB-KVBLK)/4;
  #define NB0(t,N0) do{ _Pragma("unroll") for(int g_=0;g_<4;++g_){ const f32x4_t v0_=kbl4[2*g_-16*(t)]; \
      _Pragma("unroll") for(int j_=0;j_<4;++j_){ N0[4*g_+j_]=v0_[j_]-mhat; } } }while(0)
  #define NB1(t,N1) do{ _Pragma("unroll") for(int g_=0;g_<4;++g_){ const f32x4_t v1_=kbl4[8+2*g_-16*(t)]; \
      _Pragma("unroll") for(int j_=0;j_<4;++j_){ N1[4*g_+j_]=v1_[j_]-mhat; } } }while(0)
  const int qrel=wid*QBLK+r32;
  #define CMASK(P0,P1,t) do{int jb_=3-(t); if(jb_>=0)cmask(P0,P1,jb_,qrel,hi);}while(0)
  bool resc=false;
  #define START(P0,P1) do{ const float rm=rowmax(P0,P1); resc=false; \
    { const float dl=(rm==-INFINITY)?0.f:rm; mhat=fadd_s(mhat,dl); \
      _Pragma("unroll") for(int r=0;r<16;++r){P0[r]=fsub_s(P0[r],dl);P1[r]=fsub_s(P1[r],dl);} \
      } \
    _Pragma("unroll") for(int r=0;r<16;++r)P0[r]=__builtin_amdgcn_exp2f(P0[r]); }while(0)
  #define RESC() do{ if(resc){ asm volatile("s_waitcnt lgkmcnt(0)":::"memory"); \
      _Pragma("unroll") for(int d_=0;d_<2;++d_) _Pragma("unroll") for(int r=0;r<16;++r)o[d_][r]*=wsf[crow(r,hi)]; } }while(0)
  f32x16 pA0,pA1,pB0,pB1;
  int sl_prev=0,sl_cur=0,sl_next=SLOTB;
  #define ROT() do{sl_prev=sl_cur;sl_cur=sl_next;sl_next=(sl_next==(NSLOT-1)*SLOTB)?0:sl_next+SLOTB;}while(0)
  DMA_K(2,2*SLOTB);
  WAIT_BAR(3);
  { f32x16 nb0_,nb1_; NB0(0,nb0_); NB1(0,nb1_); qkt(pA0,pA1,Kbase,qr,nb0_,nb1_,r32,hi); }asm volatile("s_nop 15\n\ts_nop 7":"+v"(pA0),"+v"(pA1));CMASK(pA0,pA1,0);
  START(pA0,pA1);
  f32x16 nbc; NB0(1,nbc);
  _Pragma("unroll") for(int r=0;r<16;++r)pA1[r]=__builtin_amdgcn_exp2f(pA1[r]);
  WAIT_BAR(0);
  DMA_K(3,0);DMA_V(1,SLOTB);
  ROT();
  kload8(kf,kp0+sl_cur);
  WAIT_BAR(2);
  s16x4 vlo[8],vhi[8]; u32x4 pw0,pw1,pw2,pw3;
  #define PKW(P,B) cvtpk_s(P[B],P[B+1])
  #define PAF(k) __builtin_bit_cast(bf16x8,pw##k)
  #define VFR(i) (bf16x8){vlo[i][0],vlo[i][1],vlo[i][2],vlo[i][3],vhi[i][0],vhi[i][1],vhi[i][2],vhi[i][3]}
  #define PIN(x) asm volatile("":"+v"(x))
  #define MX3(a,b,c) __builtin_fmaxf(__builtin_fmaxf((a),(b)),(c))
  #define GAPA(MF,A0,A1,A2,A3,W0,W1,PW) do{ MF; sacc+=A0; sacc+=A1; sacc+=A2; sacc+=A3; PIN(sacc); W0; W1; PIN(PW); SBAR(); }while(0)
  #define EX(v) __builtin_amdgcn_exp2f(v)
  #define GAPB(MF,X,B) do{ MF; X[B]=EX(X[B]); X[B+1]=EX(X[B+1]); X[B+2]=EX(X[B+2]); X[B+3]=EX(X[B+3]); PIN(X); SBAR(); }while(0)
  #define VRD(i) do{ vlo[i]=vtr(vp_+(((i)>>2)*4096+((i)&3)*1024)); vhi[i]=vtr(vp_+(((i)>>2)*4096+((i)&3)*1024+512)); }while(0)
  #define KRD(G,j) do{ if(G){ kload2(kf,kp0+sl_next,j); SBAR(); } }while(0)
  #define STEP(C0,C1,P0,P1,t,GK,GV,GL) do{ SBAR(); f32x16 nb1_; \
    const lds_cptr vp_=vp0+sl_prev; \
    VRD(0); SBAR(); float sacc=(P0[0]+P0[1]); \
    GAPA(C0=__builtin_amdgcn_mfma_f32_32x32x16_bf16(kf[0],qr[0],nbc,0,0,0), P0[2],P0[3],P0[4],P0[5],     pw0[0]=PKW(P0,0), pw0[1]=PKW(P0,2), pw0); \
    NB1(t,nb1_); VRD(4); SBAR(); GAPA(C1=__builtin_amdgcn_mfma_f32_32x32x16_bf16(kf[1],qr[0],nb1_,0,0,0), P0[6],P0[7],P0[8],P0[9],     pw0[2]=PKW(P0,4), pw0[3]=PKW(P0,6), pw0); \
    VRD(1); SBAR(); GAPA(C0=__builtin_amdgcn_mfma_f32_32x32x16_bf16(kf[2],qr[1],C0,0,0,0),   P0[10],P0[11],P0[12],P0[13], pw1[0]=PKW(P0,8), pw1[1]=PKW(P0,10), pw1); \
    VRD(5); SBAR(); GAPA(C1=__builtin_amdgcn_mfma_f32_32x32x16_bf16(kf[3],qr[1],C1,0,0,0),   P0[14],P0[15],P1[0],P1[1],   pw1[2]=PKW(P0,12),pw1[3]=PKW(P0,14), pw1); \
    VRD(2); SBAR(); GAPA(C0=__builtin_amdgcn_mfma_f32_32x32x16_bf16(kf[4],qr[2],C0,0,0,0),   P1[2],P1[3],P1[4],P1[5],     pw2[0]=PKW(P1,0), pw2[1]=PKW(P1,2), pw2); \
    VRD(6); SBAR(); GAPA(C1=__builtin_amdgcn_mfma_f32_32x32x16_bf16(kf[5],qr[2],C1,0,0,0),   P1[6],P1[7],P1[8],P1[9],     pw2[2]=PKW(P1,4), pw2[3]=PKW(P1,6), pw2); \
    VRD(3); SBAR(); GAPA(C0=__builtin_amdgcn_mfma_f32_32x32x16_bf16(kf[6],qr[3],C0,0,0,0),   P1[10],P1[11],P1[12],P1[13], pw3[0]=PKW(P1,8), pw3[1]=PKW(P1,10), pw3); \
    VRD(7); SBAR(); GAPA(C1=__builtin_amdgcn_mfma_f32_32x32x16_bf16(kf[7],qr[3],C1,0,0,0),   P1[14],P1[15],0.f,0.f,       pw3[2]=PKW(P1,12),pw3[3]=PKW(P1,14), pw3); \
    l_reg+=sacc; \
    if(GK){DMA_K((t)+3,sl_cur);} if(GV){DMA_V((t)+1,sl_next);} \
    CMASK(C0,C1,t); \
    { float a=MX3(C0[0],C0[1],C1[0]),b=MX3(C0[2],C0[3],C1[1]); a=MX3(a,C1[2],C1[3]); \
      _Pragma("unroll") for(int r=4;r<16;r+=4){a=MX3(a,C0[r],C0[r+1]);b=MX3(b,C0[r+2],C0[r+3]);a=MX3(a,C1[r],C1[r+1]);b=MX3(b,C1[r+2],C1[r+3]);} \
      float rm=__builtin_fmaxf(a,b); { auto rr=__builtin_amdgcn_permlane32_swap(__float_as_uint(rm),__float_as_uint(rm),false,false); rm=__builtin_fmaxf(__uint_as_float(rr[0]),__uint_as_float(rr[1])); } \
      resc=false; \
      if(__builtin_expect(__any(rm>(float)THRL),0)){ const float dl=__builtin_fmaxf(rm,0.f); mhat+=dl; \
        _Pragma("unroll") for(int r=0;r<16;++r){C0[r]-=dl;C1[r]-=dl;} \
        const float f=__builtin_amdgcn_exp2f(-dl); l_reg*=f; if(hi==0)wsf[r32]=f; resc=true; } } \
    SBAR(); \
    GAPB(o[0]=__builtin_amdgcn_mfma_f32_32x32x16_bf16(PAF(0),VFR(0),o[0],0,0,0), C0,0); \
    GAPB(o[1]=__builtin_amdgcn_mfma_f32_32x32x16_bf16(PAF(0),VFR(4),o[1],0,0,0), C0,4); \
    KRD(GL,0); GAPB(o[0]=__builtin_amdgcn_mfma_f32_32x32x16_bf16(PAF(1),VFR(1),o[0],0,0,0), C0,8); \
    KRD(GL,1); GAPB(o[1]=__builtin_amdgcn_mfma_f32_32x32x16_bf16(PAF(1),VFR(5),o[1],0,0,0), C0,12); \
    KRD(GL,2); GAPB(o[0]=__builtin_amdgcn_mfma_f32_32x32x16_bf16(PAF(2),VFR(2),o[0],0,0,0), C1,0); \
    KRD(GL,3); GAPB(o[1]=__builtin_amdgcn_mfma_f32_32x32x16_bf16(PAF(2),VFR(6),o[1],0,0,0), C1,4); \
    GAPB(o[0]=__builtin_amdgcn_mfma_f32_32x32x16_bf16(PAF(3),VFR(3),o[0],0,0,0), C1,8); \
    GAPB(o[1]=__builtin_amdgcn_mfma_f32_32x32x16_bf16(PAF(3),VFR(7),o[1],0,0,0), C1,12); \
    if(GL){ NB0((t)+1,nbc); } \
    }while(0)
  int t=1;
  for(;t+5<NT;t+=2){
    STEP(pB0,pB1,pA0,pA1,t,true,true,true);     WAIT_BAR(2); RESC(); ROT();
    STEP(pA0,pA1,pB0,pB1,t+1,true,true,true);   WAIT_BAR(2); RESC(); ROT();
  }
  #undef CMASK
  #define CMASK(P0,P1,t) do{int jb_=3-(t); if(jb_>=0)cmask(P0,P1,jb_,qrel,hi);}while(0)
  #define ENDW(tt) do{ if((tt)+3<NT){WAIT_BAR(2);} else if((tt)+2<NT){WAIT_BAR(1);} else {WAIT_BAR(0);} }while(0)
  for(;t+1<NT;t+=2){
    STEP(pB0,pB1,pA0,pA1,t,(t+3<NT),(t+1<NT),(t+1<NT));       ENDW(t);   RESC(); ROT();
    STEP(pA0,pA1,pB0,pB1,t+1,(t+4<NT),(t+2<NT),(t+2<NT));     ENDW(t+1); RESC(); ROT();
  }
  STEP(pB0,pB1,pA0,pA1,NT-1,false,false,false); RESC();
  { float sacc=pB0[0]+pB0[1]; _Pragma("unroll") for(int r=2;r<16;++r)sacc+=pB0[r]; _Pragma("unroll") for(int r=0;r<16;++r)sacc+=pB1[r]; l_reg+=sacc;
    pw0=(u32x4){PKW(pB0,0),PKW(pB0,2),PKW(pB0,4),PKW(pB0,6)};pw1=(u32x4){PKW(pB0,8),PKW(pB0,10),PKW(pB0,12),PKW(pB0,14)};pw2=(u32x4){PKW(pB1,0),PKW(pB1,2),PKW(pB1,4),PKW(pB1,6)};pw3=(u32x4){PKW(pB1,8),PKW(pB1,10),PKW(pB1,12),PKW(pB1,14)};
    SBAR(); pv(o,vb0+sl_cur,PAF(0),PAF(1),PAF(2),PAF(3)); }
  #undef PKW
  #undef PAF
  #undef VFR
  #undef PIN
  #undef MX3
  #undef GAPA
  #undef GAPB
  #undef EX
  #undef VRD
  #undef KRD
  #undef STEP
  #undef ENDW
  {auto rr=__builtin_amdgcn_permlane32_swap(__float_as_uint(l_reg),__float_as_uint(l_reg),false,false);l_reg=__uint_as_float(rr[0])+__uint_as_float(rr[1]);}
  if(hi==0)wsf[32+r32]=l_reg;asm volatile("s_waitcnt lgkmcnt(0)":::"memory");
  float rli[16];
  #pragma unroll
  for(int r=0;r<16;++r)rli[r]=__builtin_amdgcn_rcpf(wsf[32+crow(r,hi)]);
  bf16*Ow=O+(rowbase+q0+wid*QBLK)*DM+h*D;
  { bf16*stg=(bf16*)(shm+LDS_OST)+wid*2048;
    #pragma unroll
    for(int r=0;r<16;++r){const int orow=crow(r,hi);
      #pragma unroll
      for(int d0=0;d0<2;++d0)stg[orow*64+d0*32+r32]=__float2bfloat16(o[d0][r]*rli[r]);}
    asm volatile("s_waitcnt lgkmcnt(0)":::"memory");
    #pragma unroll
    for(int i=0;i<4;++i){const int row=i*8+(lane>>3),ch=lane&7; const u32x4 v=*(const u32x4*)(stg+row*64+ch*8); ATTN_STORE16(Ow+(long)row*DM+ch*8,v);} }
  asm volatile("s_waitcnt lgkmcnt(0)\n\ts_barrier":::"memory");
  #undef DMA_K
  #undef DMA_V
  #undef NB0
  #undef NB1
  #undef CMASK
  #undef START
  #undef RESC
  #undef ROT
}
constexpr int ATTN_LDS_BYTES=LDS_BYTES;
#undef SBAR
#undef WAIT_BAR
}

#define LAS __attribute__((address_space(3)))
typedef unsigned short bf16_t;
typedef short bf16x8 __attribute__((ext_vector_type(8)));
typedef short s16x4 __attribute__((ext_vector_type(4)));
typedef float f32x4 __attribute__((ext_vector_type(4)));
typedef float f32x16 __attribute__((ext_vector_type(16)));
typedef unsigned u32x4 __attribute__((ext_vector_type(4)));
typedef unsigned u32x2 __attribute__((ext_vector_type(2)));

constexpr int DM = 1024, NBATCH = 32, SEQ = 2048, T = NBATCH * SEQ, DFF = 2752, DFFP = 2816, INCOLS = 3080, NMODC = 9 * DM;
constexpr int NWAVES = 8, NTHR = 512;
constexpr float EPS = 1e-6f, LOG2E = 1.4426950408889634f;
constexpr size_t MiB = 1u << 20;
constexpr size_t WS_WGU1 = 0, WS_WD1 = 11 * MiB, WS_WGU2 = 17 * MiB, WS_WD2 = 28 * MiB, WS_WIN = 34 * MiB, WS_WOUT = 40 * MiB, WS_MOD = 42 * MiB,
                 WS_ROPE = 44 * MiB, WS_FL = 48 * MiB, WS_KB = 50 * MiB, WS_LSE = 52 * MiB, WS_WF = 58 * MiB, WS_BAR = 59 * MiB,
                 WS_H = 64 * MiB, WS_Y = 192 * MiB, WS_BIG = 320 * MiB, WS_OA = 704 * MiB, WS_OB = 896 * MiB, WS_END = 960 * MiB;
constexpr size_t QKV_STRIDE = (size_t)T * 512;
constexpr int LDS_BYTES = 151552;

__device__ __forceinline__ float wave_sum(float v) {
#pragma unroll
    for (int o = 1; o < 64; o <<= 1) v += __shfl_xor(v, o);
    return v;
}
__device__ __forceinline__ unsigned pk2(float lo, float hi) { return pg8::cvt_pk_bf16(lo, hi); }
__device__ __forceinline__ float bf_lo(unsigned u) { return __uint_as_float(u << 16); }
__device__ __forceinline__ float bf_hi(unsigned u) { return __uint_as_float(u & 0xffff0000u); }
#define LDS_WAIT() asm volatile("s_waitcnt lgkmcnt(0)" ::: "memory")

__device__ __forceinline__ int opaque_tid() { int t = threadIdx.x; asm volatile("" : "+v"(t)); return t; }
__device__ __forceinline__ void tr_item(const float* __restrict__ W, int ldn, int k0, int n0, bf16_t* WT, int Kd, int drow0, LAS float* scr, int lane) {
#pragma unroll 8
    for (int i = 0; i < 32; ++i) { const int kk = 2 * i + (lane >> 5); scr[kk * 33 + (lane & 31)] = W[(size_t)(k0 + kk) * ldn + n0 + (lane & 31)]; }
    LDS_WAIT();
    const int c = lane & 7;
#pragma unroll
    for (int j = 0; j < 4; ++j) { const int n = (lane >> 3) + 8 * j; const LAS float* s = scr + (8 * c) * 33 + n;
        u32x4 o; o.x = pk2(s[0 * 33], s[1 * 33]); o.y = pk2(s[2 * 33], s[3 * 33]); o.z = pk2(s[4 * 33], s[5 * 33]); o.w = pk2(s[6 * 33], s[7 * 33]);
        *(u32x4*)(WT + (size_t)(drow0 + n) * Kd + k0 + 8 * c) = o; }
    LDS_WAIT();
}

struct Args { const float* in[22]; float* out; unsigned char* ws; };

__device__ __forceinline__ void p0_phase(const Args& a, LAS unsigned char* lds, int tid, int lane, int wave) {
    unsigned char* ws = a.ws;
    const int G = gridDim.x;
    {
        LAS float* sc = (LAS float*)lds;
        const float* c = a.in[1]; const float* wada = a.in[3]; const float* bada = a.in[4]; float* MOD = (float*)(ws + WS_MOD);
        for (int it = blockIdx.x; it < NMODC / 64; it += G) {
            __syncthreads();
            for (int e = tid; e < NBATCH * DM; e += NTHR) { const float v = c[e]; sc[e] = v / (1.0f + __expf(-v)); }
            __syncthreads();
            const int j = it * 64 + lane; const int kb = wave * 128;
            float acc[32];
#pragma unroll
            for (int b = 0; b < 32; ++b) acc[b] = 0.f;
            for (int k4 = 0; k4 < 128; k4 += 4) {
                const float w0 = wada[(size_t)(kb + k4 + 0) * NMODC + j], w1 = wada[(size_t)(kb + k4 + 1) * NMODC + j],
                            w2 = wada[(size_t)(kb + k4 + 2) * NMODC + j], w3 = wada[(size_t)(kb + k4 + 3) * NMODC + j];
#pragma unroll
                for (int b = 0; b < 32; ++b) { const f32x4 s = *(const LAS f32x4*)(sc + b * DM + kb + k4); acc[b] += s[0] * w0 + s[1] * w1 + s[2] * w2 + s[3] * w3; }
            }
            __syncthreads();
            LAS float* P = (LAS float*)lds;
#pragma unroll
            for (int b = 0; b < 32; ++b) P[(wave * 32 + b) * 64 + lane] = acc[b];
            __syncthreads();
            for (int o = tid; o < 32 * 64; o += NTHR) { const int b = o >> 6, col = o & 63; float s = 0.f;
#pragma unroll
                for (int w = 0; w < 8; ++w) s += P[(w * 32 + b) * 64 + col];
                MOD[(size_t)b * NMODC + it * 64 + col] = s + bada[it * 64 + col]; }
        }
        __syncthreads();
    }
    {
        LAS float* scr = (LAS float*)(lds + wave * 16384);
        const int gw = blockIdx.x * NWAVES + wave, NGW = G * NWAVES;
        constexpr int I_G = 16 * 86, I_D = 43 * 32, I_IN = 16 * 96, I_O = 16 * 32;
        constexpr int NITEMS = 2 * (2 * I_G + I_D) + I_IN + I_O;
        for (int it = gw; it < NITEMS; it += NGW) {
            int r = it; bool done = false;
#pragma unroll
            for (int f = 0; f < 2; ++f) {
                if (done) break;
                const float* Wg = a.in[f ? 19 : 7]; const float* Wu = a.in[f ? 20 : 8]; const float* Wd = a.in[f ? 21 : 9];
                bf16_t* WGU = (bf16_t*)(ws + (f ? WS_WGU2 : WS_WGU1)); bf16_t* WD = (bf16_t*)(ws + (f ? WS_WD2 : WS_WD1));
                if (r < 2 * I_G) { const int up = r >= I_G; const int q = up ? r - I_G : r; const int kb = q / 86, nb = q % 86, n0 = 32 * nb;
                    tr_item(up ? Wu : Wg, DFF, 64 * kb, n0, WGU, DM, 256 * (n0 >> 7) + (n0 & 127) + (up ? 128 : 0), scr, lane); done = true; continue; }
                r -= 2 * I_G;
                if (r < I_D) { const int kb = r / 32, nb = r % 32; tr_item(Wd, DM, 64 * kb, 32 * nb, WD, DFFP, 32 * nb, scr, lane); done = true; continue; }
                r -= I_D;
            }
            if (done) continue;
            if (r < I_IN) { const int kb = r / 96, nb = r % 96; tr_item(a.in[12], INCOLS, 64 * kb, 32 * nb, (bf16_t*)(ws + WS_WIN), DM, 32 * nb, scr, lane); continue; }
            r -= I_IN;
            { const int kb = r / 32, nb = r % 32; tr_item(a.in[16], DM, 64 * kb, 32 * nb, (bf16_t*)(ws + WS_WOUT), DM, 32 * nb, scr, lane); }
        }
    }
    {
        const int gt = blockIdx.x * NTHR + tid, NT = G * NTHR;
        for (int e = gt; e < 2 * 128 * 128; e += NT) { const int f = e >> 14, q = e & 16383, rr = q >> 7, ch = q & 127;
            bf16_t* WGU = (bf16_t*)(ws + (f ? WS_WGU2 : WS_WGU1)); const int row = 21 * 256 + (rr < 64 ? 64 + rr : 128 + rr);
            *(u32x4*)(WGU + (size_t)row * DM + ch * 8) = (u32x4){0u, 0u, 0u, 0u}; }
        for (int e = gt; e < 2 * 1024 * 8; e += NT) { const int f = e >> 13, q = e & 8191, row = q >> 3, ch = q & 7;
            bf16_t* WD = (bf16_t*)(ws + (f ? WS_WD2 : WS_WD1)); *(u32x4*)(WD + (size_t)row * DFFP + DFF + ch * 8) = (u32x4){0u, 0u, 0u, 0u}; }
        float* WF = (float*)(ws + WS_WF);
        for (int e = gt; e < 8 * DM; e += NT) { const int j = e >> 10, k = e & 1023; WF[e] = a.in[12][(size_t)k * INCOLS + 3072 + j]; }
        float* ROPE = (float*)(ws + WS_ROPE); const int* pos = (const int*)a.in[2];
        for (int e = gt; e < T * 8; e += NT) { const int row = e >> 3, i = e & 7; const float inv = exp2f(-(float)i * 0.125f * 18.931568569324174f);
            const float ang = (float)pos[row] * inv; ROPE[(size_t)row * 16 + i] = cosf(ang); ROPE[(size_t)row * 16 + 8 + i] = sinf(ang); }
    }
}

template <bool HAS_Y, bool HAS_H, bool HAS_FL>
__device__ __forceinline__ void rowpass(const float* xin, float* xout, const bf16_t* Y, bf16_t* H, float* FL, const float* g_post, const float* g_pre,
                                        const float* MOD, int gi, float gscale, int sci, int shi, LAS const float* wfl, int lane, int wave, int b0, int nbat) {
    constexpr int R = 4;
    const int gw = blockIdx.x * NWAVES + wave, NGW = gridDim.x * NWAVES;
    const int WPB = (NGW / nbat) > 0 ? (NGW / nbat) : 1; const int wb = b0 + gw / WPB, wj = gw % WPB;
    int cur_b = -1;
    f32x4 A[4], Bv[4], Cv[4];
#pragma unroll
    for (int j = 0; j < 4; ++j) { A[j] = (f32x4){0.f, 0.f, 0.f, 0.f}; Bv[j] = A[j]; Cv[j] = A[j]; }
    for (int lr = wj * R; lr < SEQ && wb < b0 + nbat; lr += WPB * R) {
        const int row0 = wb * SEQ + lr;
        const int b = wb;
        if (b != cur_b) { cur_b = b;
#pragma unroll
            for (int j = 0; j < 4; ++j) { const int c = 4 * lane + 256 * j;
                if (HAS_Y) A[j] = *(const f32x4*)(MOD + (size_t)b * NMODC + gi * DM + c) * *(const f32x4*)(g_post + c) * gscale;
                if (HAS_H) { Bv[j] = *(const f32x4*)(g_pre + c) * (*(const f32x4*)(MOD + (size_t)b * NMODC + sci * DM + c) + 1.0f); Cv[j] = *(const f32x4*)(MOD + (size_t)b * NMODC + shi * DM + c); } } }
        f32x4 x[R][4]; u32x2 yw[R][4];
#pragma unroll
        for (int q = 0; q < R; ++q)
#pragma unroll
            for (int j = 0; j < 4; ++j) { x[q][j] = __builtin_nontemporal_load((const f32x4*)(xin + (size_t)(row0 + q) * DM + 4 * lane + 256 * j));
                if (HAS_Y) yw[q][j] = __builtin_nontemporal_load((const u32x2*)(Y + (size_t)(row0 + q) * DM + 4 * lane + 256 * j)); }
        if (HAS_Y) {
            float ss[R];
#pragma unroll
            for (int q = 0; q < R; ++q) { ss[q] = 0.f;
#pragma unroll
                for (int j = 0; j < 4; ++j) { const float y0 = bf_lo(yw[q][j].x), y1 = bf_hi(yw[q][j].x), y2 = bf_lo(yw[q][j].y), y3 = bf_hi(yw[q][j].y); ss[q] += (y0 * y0 + y1 * y1) + (y2 * y2 + y3 * y3); } }
#pragma unroll
            for (int o = 1; o < 64; o <<= 1)
#pragma unroll
                for (int q = 0; q < R; ++q) ss[q] += __shfl_xor(ss[q], o);
#pragma unroll
            for (int q = 0; q < R; ++q) { const float rstd = 1.0f / sqrtf(ss[q] * (1.0f / DM) + EPS);
#pragma unroll
                for (int j = 0; j < 4; ++j) { const f32x4 y = {bf_lo(yw[q][j].x), bf_hi(yw[q][j].x), bf_lo(yw[q][j].y), bf_hi(yw[q][j].y)};
                    x[q][j] = x[q][j] + A[j] * (y * rstd); __builtin_nontemporal_store(x[q][j], (f32x4*)(xout + (size_t)(row0 + q) * DM + 4 * lane + 256 * j)); } }
        }
        if (HAS_H) {
            float ss[R];
#pragma unroll
            for (int q = 0; q < R; ++q) { ss[q] = 0.f;
#pragma unroll
                for (int j = 0; j < 4; ++j) ss[q] += (x[q][j][0] * x[q][j][0] + x[q][j][1] * x[q][j][1]) + (x[q][j][2] * x[q][j][2] + x[q][j][3] * x[q][j][3]); }
#pragma unroll
            for (int o = 1; o < 64; o <<= 1)
#pragma unroll
                for (int q = 0; q < R; ++q) ss[q] += __shfl_xor(ss[q], o);
#pragma unroll
            for (int q = 0; q < R; ++q) { const float rstd = 1.0f / sqrtf(ss[q] * (1.0f / DM) + EPS);
                f32x4 h[4];
#pragma unroll
                for (int j = 0; j < 4; ++j) { h[j] = (x[q][j] * rstd) * Bv[j] + Cv[j];
                    u32x2 w; w.x = pk2(h[j][0], h[j][1]); w.y = pk2(h[j][2], h[j][3]); *(u32x2*)(H + (size_t)(row0 + q) * DM + 4 * lane + 256 * j) = w; }
                if (HAS_FL) {
                    float myv = 0.f;
#pragma unroll
                    for (int f = 0; f < 8; ++f) { float d = 0.f;
#pragma unroll
                        for (int j = 0; j < 4; ++j) { const f32x4 wv = *(const LAS f32x4*)(wfl + f * DM + 4 * lane + 256 * j); d += (h[j][0] * wv[0] + h[j][1] * wv[1]) + (h[j][2] * wv[2] + h[j][3] * wv[3]); }
                        d = wave_sum(d); if (lane == f) myv = d; }
                    if (lane < 8) FL[(size_t)(row0 + q) * 8 + lane] = myv;
                }
            }
        }
    }
}

namespace att {
constexpr int KP = 144;
constexpr float C2 = 0.125f * 1.4426950408889634f;
#define MFMA32(a, b, c) __builtin_amdgcn_mfma_f32_32x32x16_bf16((a), (b), (c), 0, 0, 0)
__device__ __forceinline__ s16x4 vtr(LAS const unsigned char* p) { return __builtin_bit_cast(s16x4, __builtin_amdgcn_ds_read_tr16_b64_v4i16((LAS s16x4*)p)); }
__device__ __forceinline__ bf16x8 pack8(const f32x16& x, int s) {
    u32x4 p; p.x = pk2(x[8 * s + 0], x[8 * s + 1]); p.y = pk2(x[8 * s + 2], x[8 * s + 3]); p.z = pk2(x[8 * s + 4], x[8 * s + 5]); p.w = pk2(x[8 * s + 6], x[8 * s + 7]);
    return __builtin_bit_cast(bf16x8, p);
}
template <int NKB, bool M0, bool M1, bool BIAS>
__device__ __forceinline__ void step(LAS const unsigned char* kbuf, LAS const unsigned char* vbuf, LAS const float* kbias, const bf16x8 (&qf)[4], f32x16 (&o)[2], float& m, float& l,
                                     int lo0, int hi0, int lo1, int hi1, int r, int h, int lane) {
    f32x16 s[NKB];
#pragma unroll
    for (int kb = 0; kb < NKB; ++kb) {
#pragma unroll
        for (int i = 0; i < 16; ++i) s[kb][i] = 0.f;
#pragma unroll
        for (int ss = 0; ss < 4; ++ss) { const bf16x8 kf = *(const LAS bf16x8*)(kbuf + (32 * kb + r) * KP + 32 * ss + 16 * h); s[kb] = MFMA32(kf, qf[ss], s[kb]); }
    }
    float mx = -INFINITY;
#pragma unroll
    for (int kb = 0; kb < NKB; ++kb) {
        const bool MK = kb == 0 ? M0 : M1; const int lo = (kb == 0 ? lo0 : lo1) - 4 * h, hi = (kb == 0 ? hi0 : hi1) - 4 * h; const unsigned span = (unsigned)(hi - lo);
#pragma unroll
        for (int g = 0; g < 4; ++g) {
            f32x4 bv = {0.f, 0.f, 0.f, 0.f};
            if (BIAS) bv = *(const LAS f32x4*)(kbias + 32 * kb + 8 * g + 4 * h);
#pragma unroll
            for (int j = 0; j < 4; ++j) { const int i = 4 * g + j; float v = s[kb][i] * C2 + bv[j];
                if (MK) { const int c = j + 8 * g; v = ((unsigned)(c - lo) <= span && hi >= lo) ? v : -INFINITY; }
                s[kb][i] = v; mx = fmaxf(mx, v); }
        }
    }
    mx = fmaxf(mx, __shfl_xor(mx, 32));
    const float mn = fmaxf(m, mx); const float alpha = __builtin_amdgcn_exp2f(m - mn); m = mn;
    float ps = 0.f;
#pragma unroll
    for (int kb = 0; kb < NKB; ++kb)
#pragma unroll
        for (int i = 0; i < 16; ++i) { const float p = __builtin_amdgcn_exp2f(s[kb][i] - mn); s[kb][i] = p; ps += p; }
    l = l * alpha + ps;
#pragma unroll
    for (int i = 0; i < 16; ++i) { o[0][i] *= alpha; o[1][i] *= alpha; }
    const int q4 = (lane & 15) >> 2, p4 = lane & 3, blk = (lane >> 4) & 1;
    LAS const unsigned char* vb = vbuf + (4 * h + q4) * KP + 32 * blk + 8 * p4;
#pragma unroll
    for (int kb = 0; kb < NKB; ++kb)
#pragma unroll
        for (int s2 = 0; s2 < 2; ++s2) { const bf16x8 pf = pack8(s[kb], s2);
#pragma unroll
            for (int db = 0; db < 2; ++db) { const s16x4 a0 = vtr(vb + (32 * kb + 16 * s2) * KP + 64 * db), a1 = vtr(vb + (32 * kb + 16 * s2 + 8) * KP + 64 * db);
                const bf16x8 vf = __builtin_shufflevector(a0, a1, 0, 1, 2, 3, 4, 5, 6, 7); o[db] = MFMA32(vf, pf, o[db]); } }
}
__device__ __forceinline__ float finish(f32x16 (&o)[2], float l, bf16_t* orow, int h) {
    const float lt = l + __shfl_xor(l, 32); const float inv = 1.0f / lt;
#pragma unroll
    for (int db = 0; db < 2; ++db)
#pragma unroll
        for (int g = 0; g < 4; ++g) { u32x2 w; w.x = pk2(o[db][4 * g + 0] * inv, o[db][4 * g + 1] * inv); w.y = pk2(o[db][4 * g + 2] * inv, o[db][4 * g + 3] * inv);
            *(u32x2*)(orow + 32 * db + 8 * g + 4 * h) = w; }
    return lt;
}

__device__ __forceinline__ void a_phase(const bf16_t* Q, const bf16_t* K, const bf16_t* V, bf16_t* OA, float* LSE, LAS unsigned char* lds, int tid, int lane, int wave, int b0, int nbat) {
    const int r = lane & 31, h = lane >> 5, half = wave >> 2, w4 = wave & 3, t256 = tid & 255;
    LAS unsigned char* kbase = lds + half * (2 * 256 * KP); LAS unsigned char* vbase = kbase + 256 * KP;
    for (int it = blockIdx.x; it < nbat * 8 * 24; it += gridDim.x) {
        const int su = b0 * 8 * 48 + 2 * it + half; const int bh = su / 48, u = su % 48, p = u >> 4, v = u & 15, b = bh >> 3, hd = bh & 7;
        const int d = (p == 0) ? 1 : (p == 1 ? 4 : 16); const int cls = (p == 0) ? 0 : (p == 1 ? (v >> 2) : v); const int n = (p == 0) ? v : (p == 1 ? (v & 3) : 0);
        __syncthreads();
#pragma unroll
        for (int bt = 0; bt < 2; ++bt) {
            u32x4 kr[4], vr[4];
#pragma unroll
            for (int i = 0; i < 4; ++i) { const int idx = t256 + 256 * (4 * bt + i); const int j = idx >> 3, ch = idx & 7; const int mk = 128 * n - 128 + j;
                if (mk >= 0) { const size_t row = (size_t)b * SEQ + mk * d + cls; kr[i] = *(const u32x4*)(K + row * 512 + hd * 64 + ch * 8); vr[i] = *(const u32x4*)(V + row * 512 + hd * 64 + ch * 8); }
                else { kr[i] = (u32x4){0u, 0u, 0u, 0u}; vr[i] = kr[i]; } }
#pragma unroll
            for (int i = 0; i < 4; ++i) { const int idx = t256 + 256 * (4 * bt + i); const int j = idx >> 3, ch = idx & 7;
                *(LAS u32x4*)(kbase + j * KP + ch * 16) = kr[i]; *(LAS u32x4*)(vbase + j * KP + ch * 16) = vr[i]; }
        }
        const int mq = 128 * n + 32 * w4 + r; const size_t qrow = (size_t)b * SEQ + mq * d + cls;
        bf16x8 qf[4];
#pragma unroll
        for (int ss = 0; ss < 4; ++ss) qf[ss] = *(const bf16x8*)(Q + qrow * 512 + hd * 64 + 16 * ss + 8 * h);
        __syncthreads();
        f32x16 o[2];
#pragma unroll
        for (int i = 0; i < 16; ++i) { o[0][i] = 0.f; o[1][i] = 0.f; }
        float m = -1e30f, l = 0.f;
        const int jlo = (n == 0) ? max(32 * w4 + r, 128) : 32 * w4 + r, jhi = 128 + 32 * w4 + r;
        LAS const unsigned char* kw = kbase + 32 * w4 * KP; LAS const unsigned char* vw = vbase + 32 * w4 * KP;
        if (n > 0) {
            step<2, true, false, false>(kw, vw, nullptr, qf, o, m, l, r, 31, 0, 31, r, h, lane);
            step<2, false, false, false>(kw + 64 * KP, vw + 64 * KP, nullptr, qf, o, m, l, 0, 0, 0, 0, r, h, lane);
        } else {
            if (w4 + 1 >= 4) step<2, true, true, false>(kw, vw, nullptr, qf, o, m, l, jlo - 32 * w4, jhi - 32 * w4, jlo - 32 * (w4 + 1), jhi - 32 * (w4 + 1), r, h, lane);
            if (w4 + 3 >= 4) step<2, true, true, false>(kw + 64 * KP, vw + 64 * KP, nullptr, qf, o, m, l, jlo - 32 * (w4 + 2), jhi - 32 * (w4 + 2), jlo - 32 * (w4 + 3), jhi - 32 * (w4 + 3), r, h, lane);
        }
        step<1, true, false, false>(kw + 128 * KP, vw + 128 * KP, nullptr, qf, o, m, l, jlo - 32 * (w4 + 4), jhi - 32 * (w4 + 4), 0, 0, r, h, lane);
        const float lt = finish(o, l, OA + ((size_t)p * T + qrow) * 512 + hd * 64, h);
        if (h == 0) LSE[((size_t)p * T + qrow) * 8 + hd] = m + __log2f(lt);
    }
    __syncthreads();
}
}


__device__ __forceinline__ void b_phase2(const bf16_t* Q, const bf16_t* K, const bf16_t* V, const float* KBIAS, bf16_t* O, unsigned char* shm, int tid, int b0, int nbat) {
    for (int it = blockIdx.x; it < nbat * 8 * 2; it += gridDim.x) {
        const int bh = b0 * 8 + (it >> 1), set = it & 1;
        const int t2 = opaque_tid();
        const f32x4 v = *(const f32x4*)(KBIAS + (size_t)bh * SEQ + 4 * t2);
        *(LAS f32x4*)((LAS unsigned char*)shm + attn_body::LDS_KB + 16 * t2) = v;
        __syncthreads();
        for (int k = 0; k < 4; ++k) { const int qb = (k & 1) ? (2 * (k >> 1) + set) : (7 - 2 * (k >> 1) - set);
            attn_body::attn_unit<8>(bh >> 3, bh & 7, qb, (const attn_body::bf16*)Q, (const attn_body::bf16*)K, (const attn_body::bf16*)V, (attn_body::bf16*)O, (char*)shm); }
    }
    __syncthreads();
}

__device__ __forceinline__ void merge_pass(const bf16_t* OA, const float* LSE, const bf16_t* OB, const float* g_a, const float* g_b, bf16_t* MG, int lane, int wave, int r0, int nrows) {
    constexpr int R = 4;
    const int gw = blockIdx.x * NWAVES + wave, NGW = gridDim.x * NWAVES;
    f32x4 ga0 = *(const f32x4*)(g_a + 8 * lane), ga1 = *(const f32x4*)(g_a + 8 * lane + 4), gb0 = *(const f32x4*)(g_b + 8 * lane), gb1 = *(const f32x4*)(g_b + 8 * lane + 4);
    const int hd = lane >> 3;
    for (int rowb = r0 + gw * R; rowb < r0 + nrows; rowb += NGW * R) {
        float ls[R][3]; u32x4 w[R][3], wb[R];
#pragma unroll
        for (int q = 0; q < R; ++q) { const int row = rowb + q;
#pragma unroll
            for (int p = 0; p < 3; ++p) { ls[q][p] = LSE[((size_t)p * T + row) * 8 + hd]; w[q][p] = *(const u32x4*)(OA + ((size_t)p * T + row) * 512 + 8 * lane); }
            wb[q] = *(const u32x4*)(OB + (size_t)row * 512 + 8 * lane); }
        float va[R][8], vb[R][8], sa[R], sb[R];
#pragma unroll
        for (int q = 0; q < R; ++q) {
            const float mx = fmaxf(ls[q][0], fmaxf(ls[q][1], ls[q][2]));
            float e[3]; e[0] = __builtin_amdgcn_exp2f(ls[q][0] - mx); e[1] = __builtin_amdgcn_exp2f(ls[q][1] - mx); e[2] = __builtin_amdgcn_exp2f(ls[q][2] - mx);
            const float inv = 1.0f / (e[0] + e[1] + e[2]);
#pragma unroll
            for (int k = 0; k < 4; ++k) {
                float lo = 0.f, hi = 0.f;
#pragma unroll
                for (int p = 0; p < 3; ++p) { lo += e[p] * bf_lo(w[q][p][k]); hi += e[p] * bf_hi(w[q][p][k]); }
                va[q][2 * k] = lo * inv; va[q][2 * k + 1] = hi * inv; vb[q][2 * k] = bf_lo(wb[q][k]); vb[q][2 * k + 1] = bf_hi(wb[q][k]);
            }
            sa[q] = 0.f; sb[q] = 0.f;
#pragma unroll
            for (int k = 0; k < 8; ++k) { sa[q] += va[q][k] * va[q][k]; sb[q] += vb[q][k] * vb[q][k]; }
        }
#pragma unroll
        for (int o = 1; o < 64; o <<= 1)
#pragma unroll
            for (int q = 0; q < R; ++q) { sa[q] += __shfl_xor(sa[q], o); sb[q] += __shfl_xor(sb[q], o); }
#pragma unroll
        for (int q = 0; q < R; ++q) { const int row = rowb + q;
            const float ra = 1.0f / sqrtf(sa[q] * (1.0f / 512.0f) + EPS), rb = 1.0f / sqrtf(sb[q] * (1.0f / 512.0f) + EPS);
            u32x4 oa, ob;
            oa.x = pk2(va[q][0] * ra * ga0[0], va[q][1] * ra * ga0[1]); oa.y = pk2(va[q][2] * ra * ga0[2], va[q][3] * ra * ga0[3]); oa.z = pk2(va[q][4] * ra * ga1[0], va[q][5] * ra * ga1[1]); oa.w = pk2(va[q][6] * ra * ga1[2], va[q][7] * ra * ga1[3]);
            ob.x = pk2(vb[q][0] * rb * gb0[0], vb[q][1] * rb * gb0[1]); ob.y = pk2(vb[q][2] * rb * gb0[2], vb[q][3] * rb * gb0[3]); ob.z = pk2(vb[q][4] * rb * gb1[0], vb[q][5] * rb * gb1[1]); ob.w = pk2(vb[q][6] * rb * gb1[2], vb[q][7] * rb * gb1[3]);
            *(u32x4*)(MG + (size_t)row * DM + 8 * lane) = oa; *(u32x4*)(MG + (size_t)row * DM + 512 + 8 * lane) = ob; }
    }
}

__device__ __forceinline__ void cumsum_phase(const float* FL, const float* bforget, float* KBIAS, LAS unsigned char* lds, int tid, int lane, int wave, int b0, int nbat) {
    LAS float* wt = (LAS float*)lds;
    for (int it = b0 * 8 + blockIdx.x; it < (b0 + nbat) * 8; it += gridDim.x) {
        const int b = it >> 3, hd = it & 7; const float bf = bforget[hd];
        float v[4];
#pragma unroll
        for (int i = 0; i < 4; ++i) { const float z = FL[((size_t)b * SEQ + 4 * tid + i) * 8 + hd] + bf; v[i] = fminf(z, 0.f) - log1pf(__expf(-fabsf(z))); }
        v[1] += v[0]; v[2] += v[1]; v[3] += v[2];
        float sc = v[3];
#pragma unroll
        for (int o = 1; o < 64; o <<= 1) { const float t = __shfl_up(sc, o); if (lane >= o) sc += t; }
        __syncthreads();
        if (lane == 63) wt[wave] = sc;
        __syncthreads();
        float off = sc - v[3];
        for (int w = 0; w < wave; ++w) off += wt[w];
        f32x4 o4 = {-(off + v[0]) * LOG2E, -(off + v[1]) * LOG2E, -(off + v[2]) * LOG2E, -(off + v[3]) * LOG2E};
        *(f32x4*)(KBIAS + (size_t)it * SEQ + 4 * tid) = o4;
    }
    __syncthreads();
}

#define XB_TMO      128
#define XB_XCNT(j)  (256  + 64 * (j))
#define XB_XSUB(j)  (1280 + 64 * (j))
#define XB_XGEN(j)  (2304 + 64 * (j))
#define XB_TOP      3328
#define XB_TOPGEN   3392
#define XCD_BAR_WORDS 3456
#define XB_SPIN_CAP (1u << 18)

__device__ __forceinline__ unsigned xb_ld(unsigned* p)              { return __hip_atomic_load(p, __ATOMIC_RELAXED, __HIP_MEMORY_SCOPE_AGENT); }
__device__ __forceinline__ unsigned xb_add(unsigned* p, unsigned v) { return __hip_atomic_fetch_add(p, v, __ATOMIC_RELAXED, __HIP_MEMORY_SCOPE_AGENT); }
__device__ __forceinline__ unsigned xb_xcc_id() { return (unsigned)__builtin_amdgcn_s_getreg((3 << 11) | 20) & 0xFu; }
#define XB_SPIN(cond, bar) do { unsigned _sp = 0; while (cond) { __builtin_amdgcn_s_sleep(1); \
    if ((++_sp & 255u) == 0u) { if (xb_ld(&(bar)[XB_TMO])) break; if (_sp > XB_SPIN_CAP) { atomicAdd(&(bar)[XB_TMO], 1u); break; } } } } while (0)

struct XcdBarrier {
    unsigned* bar; unsigned x;
    volatile LAS unsigned* st;
};

__device__ __forceinline__ XcdBarrier xcd_barrier_post(unsigned* bar, volatile LAS unsigned* st) {
    XcdBarrier b; b.bar = bar; b.x = xb_xcc_id(); b.st = st;
    if (threadIdx.x == 0) (void)xb_add(&bar[XB_XCNT(b.x)], 1u);
    return b;
}
__device__ __forceinline__ void xcd_barrier_complete(unsigned* bar, unsigned x, unsigned& nloc, unsigned& nx) {
    const unsigned G = gridDim.x * gridDim.y * gridDim.z;
    unsigned sum, cnt, mine, sp = 0u;
    for (;;) {
        sum = 0u; cnt = 0u; mine = 0u;
#pragma unroll
        for (unsigned j = 0; j < 16; ++j) { const unsigned c = xb_ld(&bar[XB_XCNT(j)]); sum += c; cnt += (c > 0u) ? 1u : 0u; mine = (j == x) ? c : mine; }
        if (sum == G) break;
        __builtin_amdgcn_s_sleep(1);
        if ((++sp & 255u) == 0u) { if (xb_ld(&bar[XB_TMO])) break; if (sp > XB_SPIN_CAP) { atomicAdd(&bar[XB_TMO], 1u); break; } }
    }
    nloc = mine > 0u ? mine : 1u; nx = cnt > 0u ? cnt : 1u;
}

__device__ __forceinline__ void xcd_barrier(const XcdBarrier& b) {
    asm volatile("s_waitcnt vmcnt(0)" ::: "memory");
    __syncthreads();
    if (threadIdx.x == 0) {
        unsigned* bar = b.bar;
        __builtin_amdgcn_s_waitcnt(0);
        unsigned nloc = b.st[0], nx = b.st[1];
        if (nloc == 0u) { xcd_barrier_complete(bar, b.x, nloc, nx); b.st[0] = nloc; b.st[1] = nx; }
        const unsigned old = xb_add(&bar[XB_XSUB(b.x)], 1u);
        const unsigned gen = old / nloc;
        if (old + 1u == (gen + 1u) * nloc) {
            __builtin_amdgcn_fence(__ATOMIC_RELEASE, "agent");
            asm volatile("s_waitcnt vmcnt(0)" ::: "memory");
            const unsigned og = xb_add(&bar[XB_TOP], 1u);
            const unsigned tg = og / nx;
            if (og + 1u == (tg + 1u) * nx) xb_add(&bar[XB_TOPGEN], 1u);
            else XB_SPIN(xb_ld(&bar[XB_TOPGEN]) == tg, bar);
            __builtin_amdgcn_fence(__ATOMIC_ACQUIRE, "agent");
            xb_add(&bar[XB_XGEN(b.x)], 1u);
            asm volatile("s_waitcnt vmcnt(0)" ::: "memory");
        } else {
            XB_SPIN(xb_ld(&bar[XB_XGEN(b.x)]) == gen, bar);
            __builtin_amdgcn_fence(__ATOMIC_ACQUIRE, "agent");
            asm volatile("s_waitcnt vmcnt(0)" ::: "memory");
        }
    }
    __syncthreads();
}

__global__ void __launch_bounds__(NTHR, 2) mega_fwd(Args a) {
    extern __shared__ __attribute__((aligned(16))) unsigned char lds_raw[];
    LAS unsigned char* lds = (LAS unsigned char*)lds_raw;
    cg::grid_group grid = cg::this_grid();
#define IDS() const int tid = opaque_tid(), lane = tid & 63, wave = __builtin_amdgcn_readfirstlane(tid >> 6); (void)lane; (void)wave
    unsigned char* ws = a.ws;
    bf16_t* H = (bf16_t*)(ws + WS_H); bf16_t* Y = (bf16_t*)(ws + WS_Y); bf16_t* HID = (bf16_t*)(ws + WS_BIG); bf16_t* QKV = (bf16_t*)(ws + WS_BIG);
    bf16_t* OA = (bf16_t*)(ws + WS_OA); bf16_t* OB = (bf16_t*)(ws + WS_OB);
    float* MOD = (float*)(ws + WS_MOD); float* FL = (float*)(ws + WS_FL); float* KBIAS = (float*)(ws + WS_KB); float* LSE = (float*)(ws + WS_LSE);
    const float* x = a.in[0]; float* out = a.out;
    const int G = gridDim.x, cb = blockIdx.x;

    volatile LAS unsigned* bst = (volatile LAS unsigned*)(lds + 151040);
    unsigned* barw = (unsigned*)(ws + WS_BAR);
    { IDS();
    if (tid < 2) bst[tid] = 0u;
    if (blockIdx.x == 0) for (int i = tid; i < XCD_BAR_WORDS; i += NTHR) barw[i] = 0u; }
    { IDS(); p0_phase(a, lds, tid, lane, wave); }
    grid.sync();
    const XcdBarrier bar = xcd_barrier_post(barw, bst);
    for (int st = 1; st <= 13; ++st) {
        const bool r0job = (st == 1 || st == 4 || st == 7 || st == 9 || st == 12);
        const bool r1job = (st == 2 || st == 5 || st == 8 || st == 10 || st == 13);
        const bool odd = (blockIdx.x & 1) != 0;
        const int first = r0job ? (odd ? 0 : 1) : (r1job ? (odd ? 1 : 0) : 0);
        for (int kk = 0; kk < 2; ++kk) {
            const int grp = kk == 0 ? first : 1 - first; const int ph = st - grp;
            if (ph < 1 || ph > 12) continue;
            const int b0 = grp * (NBATCH / 2); const size_t r0 = (size_t)grp * (T / 2); constexpr int NB2 = NBATCH / 2, M2 = T / 2;
            if (ph == 1) { IDS(); rowpass<false, true, false>(x, nullptr, nullptr, H, nullptr, nullptr, a.in[5], MOD, 0, 0.f, 1, 0, nullptr, lane, wave, b0, NB2); }
            else if (ph == 2 || ph == 10) { const bool f2 = ph == 10;
                pg8::Gemm g{H + r0 * DM, (const bf16_t*)(ws + (f2 ? WS_WGU2 : WS_WGU1)), M2, 2 * DFFP, DM}; pg8::StaticOrder S; S.init(M2, 2 * DFFP, G, cb); pg8::EpiSwiglu E{HID + r0 * DFFP, DFFP};
                pg8::gemm_phase<pg8::EpiSwiglu, pg8::StaticOrder, true, true>(lds, g, S, E); }
            else if (ph == 3 || ph == 8 || ph == 11) { const bool o = ph == 8;
                pg8::Gemm g{o ? H + r0 * DM : HID + r0 * DFFP, (const bf16_t*)(ws + (o ? WS_WOUT : (ph == 3 ? WS_WD1 : WS_WD2))), M2, DM, o ? DM : DFFP}; pg8::StaticOrder S; S.init(M2, DM, G, cb); pg8::EpiPlain E{Y + r0 * DM, DM};
                pg8::gemm_phase<pg8::EpiPlain, pg8::StaticOrder, true, true>(lds, g, S, E); }
            else if (ph == 4) { IDS(); LAS float* wfl = (LAS float*)lds; const float* WF = (const float*)(ws + WS_WF);
                for (int e = tid; e < 8 * DM; e += NTHR) wfl[e] = WF[e];
                __syncthreads();
                rowpass<true, true, true>(x, out, Y, H, FL, a.in[6], a.in[10], MOD, 2, 0.5f, 4, 3, wfl, lane, wave, b0, NB2);
                __syncthreads(); }
            else if (ph == 5) { { IDS(); cumsum_phase(FL, a.in[13], KBIAS, lds, tid, lane, wave, b0, NB2); }
                pg8::Gemm g{H + r0 * DM, (const bf16_t*)(ws + WS_WIN), M2, 3072, DM}; pg8::StaticOrder S; S.init(M2, 3072, G, cb); pg8::EpiQKV E{QKV + r0 * 512, QKV_STRIDE, (const float*)(ws + WS_ROPE) + r0 * 16};
                pg8::gemm_phase<pg8::EpiQKV, pg8::StaticOrder, true, true>(lds, g, S, E); }
            else if (ph == 6) { { IDS(); b_phase2(QKV + 3 * QKV_STRIDE, QKV + 4 * QKV_STRIDE, QKV + 5 * QKV_STRIDE, KBIAS, OB, lds_raw, tid, b0, NB2); }
                { IDS(); att::a_phase(QKV, QKV + QKV_STRIDE, QKV + 2 * QKV_STRIDE, OA, LSE, lds, tid, lane, wave, b0, NB2); } }
            else if (ph == 7) { IDS(); merge_pass(OA, LSE, OB, a.in[14], a.in[15], H, lane, wave, (int)r0, M2); }
            else if (ph == 9) { IDS(); rowpass<true, true, false>(out, out, Y, H, nullptr, a.in[11], a.in[17], MOD, 5, 1.0f, 7, 6, nullptr, lane, wave, b0, NB2); }
            else { IDS(); rowpass<true, false, false>(out, out, Y, nullptr, nullptr, a.in[18], nullptr, MOD, 8, 0.5f, 0, 0, nullptr, lane, wave, b0, NB2); }
        }
        if (st < 13) xcd_barrier(bar);
    }
}

extern "C" void kernel_launch(void* const* d_in, const int* in_sizes, int n_in, void* d_out, int out_size, void* d_ws, size_t ws_size, hipStream_t stream) {
    static int grid = 0;
    if (grid == 0) {
        if (n_in != 22 || in_sizes[0] != T * DM || out_size != T * DM || ws_size < WS_END) { fprintf(stderr, "kernel_launch: unexpected shapes (n_in %d, ws %zu)\n", n_in, ws_size); grid = -1; return; }
        int dev = 0, cus = 0, per_cu = 0;
        (void)hipGetDevice(&dev); (void)hipDeviceGetAttribute(&cus, hipDeviceAttributeMultiprocessorCount, dev);
        if (hipFuncSetAttribute((const void*)mega_fwd, hipFuncAttributeMaxDynamicSharedMemorySize, LDS_BYTES) != hipSuccess) { fprintf(stderr, "kernel_launch: hipFuncSetAttribute failed\n"); grid = -1; return; }
        if (hipOccupancyMaxActiveBlocksPerMultiprocessor(&per_cu, (const void*)mega_fwd, NTHR, LDS_BYTES) != hipSuccess || per_cu < 1) { fprintf(stderr, "kernel_launch: occupancy query says %d\n", per_cu); per_cu = 1; }
        (void)hipGetLastError();
        grid = cus;
    }
    if (grid < 0) return;
    Args a{};
    for (int i = 0; i < 22; ++i) a.in[i] = (const float*)d_in[i];
    a.out = (float*)d_out; a.ws = (unsigned char*)d_ws;
    void* args[] = {&a};
    hipError_t e = hipLaunchCooperativeKernel((const void*)mega_fwd, dim3(grid), dim3(NTHR), args, LDS_BYTES, stream);
    if (e != hipSuccess) fprintf(stderr, "kernel_launch: cooperative launch failed: %s (grid %d)\n", hipGetErrorString(e), grid);
}
```

```cpp
#include <hip/hip_runtime.h>
#include <hip/hip_cooperative_groups.h>
#include <cstdio>
#include <cstdint>
namespace cg = cooperative_groups;
namespace pg8 {
#define PG8_LAS __attribute__((address_space(3)))
typedef unsigned short bf16_t;
typedef short bf16x8 __attribute__((ext_vector_type(8)));
typedef float f32x4 __attribute__((ext_vector_type(4)));
typedef unsigned u32x4 __attribute__((ext_vector_type(4)));
constexpr int BM = 256, BK = 64, HALF = 128, HTB = HALF * BK * 2  , STAGE_BYTES = 8 * HTB, NXCD = 8, WGM = 4;

__host__ __device__ __forceinline__ int lds_byte(int r, int c) { const int st = (r >> 4) * 2 + (c >> 5), rr = r & 15, cc = c & 31, ob = rr * 64 + cc * 2; return st * 1024 + (ob ^ (((ob >> 9) & 1) << 5)); }
__host__ __device__ __forceinline__ void stage_rc(int b, int& R, int& C) { const int st = b / 1024, sb = b % 1024, swz = sb ^ (((sb >> 9) & 1) << 5); R = (st >> 1) * 16 + swz / 64; C = (st & 1) * 32 + (swz % 64) / 2; }
__host__ __device__ __forceinline__ int perm32(int rho) { const int n = rho >> 4, i = rho & 15; return 8 * (i >> 2) + 4 * n + (i & 3); }

struct Unit { int pm, pn; };
struct Gemm { const bf16_t* A; const bf16_t* Bt; int M, N, K; int ablk; };

struct StaticOrder {
    int nM, nN, nwg, G, c;
    __host__ __device__ void init(int M, int N, int G_, int c_) { nM = M / BM; nN = N / BM; nwg = nM * nN; G = G_; c = c_; }
    __host__ __device__ bool next(int i, Unit& u) const {
        const long L = (long)i * G + c; if (L >= nwg) return false;
        int wgid = (int)L; { const int q = nwg / NXCD, r = nwg % NXCD, xcd = wgid % NXCD, off = wgid / NXCD; wgid = (xcd < r ? xcd * (q + 1) : r * (q + 1) + (xcd - r) * q) + off; }
        const int nig = WGM * nN, gid = wgid / nig, fm = gid * WGM, gsz = (nM - fm) < WGM ? (nM - fm) : WGM;
        u.pm = fm + ((wgid % nig) % gsz); u.pn = (wgid % nig) / gsz; return true;
    }
    __device__ __forceinline__ void a_ready(const Unit&) const {}
    __device__ __forceinline__ void done(const Unit&) const {}
};


__device__ __forceinline__ unsigned cvt_pk_bf16(float lo, float hi) { unsigned r; asm volatile("v_cvt_pk_bf16_f32 %0, %1, %2" : "=v"(r) : "v"(lo), "v"(hi)); return r; }
typedef unsigned u32x4 __attribute__((ext_vector_type(4)));

struct EpiPlain {
    static constexpr bool PERM = true, AFTER_DRAIN = false;
    bf16_t* O; int ldc;
    __device__ __forceinline__ void operator()(const f32x4 (&acc)[2][2][4][2], const Unit& u, int wr, int wc, int fr, int fq) const {
        const int row0 = u.pm * BM + wr * 64 + fr; const int col0 = u.pn * BM + wc * 32 + 8 * fq;
#pragma unroll
        for (int ai = 0; ai < 2; ++ai)
#pragma unroll
            for (int m = 0; m < 4; ++m) { bf16_t* rowp = O + (size_t)(row0 + ai * HALF + m * 16) * ldc + col0;
#pragma unroll
                for (int bj = 0; bj < 2; ++bj) { const f32x4 v0 = acc[ai][bj][m][0], v1 = acc[ai][bj][m][1];
                    u32x4 w; w.x = cvt_pk_bf16(v0[0], v0[1]); w.y = cvt_pk_bf16(v0[2], v0[3]); w.z = cvt_pk_bf16(v1[0], v1[1]); w.w = cvt_pk_bf16(v1[2], v1[3]);
                    *(u32x4*)(rowp + bj * HALF) = w; } }
    }
};
__device__ __forceinline__ float silu_mul(float g, float u) { return g * u * __builtin_amdgcn_rcpf(1.0f + __builtin_amdgcn_exp2f(-1.4426950408889634f * g)); }
struct EpiSwiglu {
    static constexpr bool PERM = true, AFTER_DRAIN = false;
    bf16_t* O; int ldc;
    __device__ __forceinline__ void operator()(const f32x4 (&acc)[2][2][4][2], const Unit& u, int wr, int wc, int fr, int fq) const {
        bf16_t* blk = O + (((size_t)u.pm * (ldc / 32) + u.pn * 4 + wc) * 256 + wr * 64 + fr) * 32 + 8 * fq;
#pragma unroll
        for (int ai = 0; ai < 2; ++ai)
#pragma unroll
            for (int m = 0; m < 4; ++m) { bf16_t* rowp = blk + (ai * HALF + m * 16) * 32;
                const f32x4 g0 = acc[ai][0][m][0], g1 = acc[ai][0][m][1], u0 = acc[ai][1][m][0], u1 = acc[ai][1][m][1];
                u32x4 w;
                w.x = cvt_pk_bf16(silu_mul(g0[0], u0[0]), silu_mul(g0[1], u0[1])); w.y = cvt_pk_bf16(silu_mul(g0[2], u0[2]), silu_mul(g0[3], u0[3]));
                w.z = cvt_pk_bf16(silu_mul(g1[0], u1[0]), silu_mul(g1[1], u1[1])); w.w = cvt_pk_bf16(silu_mul(g1[2], u1[2]), silu_mul(g1[3], u1[3]));
                *(u32x4*)rowp = w; }
    }
};
struct EpiQKV {
    static constexpr bool PERM = true, AFTER_DRAIN = false;
    bf16_t* O; size_t stride; const float* rope;
    __device__ __forceinline__ void operator()(const f32x4 (&acc)[2][2][4][2], const Unit& u, int wr, int wc, int fr, int fq) const {
        const int t = u.pn >> 1; const int colt = (u.pn & 1) * BM;
        bf16_t* base = O + (size_t)t * stride;
        const int row0 = u.pm * BM + wr * 64 + fr; const int col0 = colt + wc * 32 + 8 * fq;
        const bool rot = (t < 2) && ((wc & 1) == 0);
        const float sgn = (fq == 0) ? -1.f : 1.f;
        const float qsc = (t == 3) ? 0.18033688011112042f : 1.0f;
#pragma unroll
        for (int ai = 0; ai < 2; ++ai)
#pragma unroll
            for (int m = 0; m < 4; ++m) { const int row = row0 + ai * HALF + m * 16; bf16_t* rowp = base + (size_t)row * 512 + col0;
                f32x4 c0 = {1.f, 1.f, 1.f, 1.f}, c1 = c0, s0 = {0.f, 0.f, 0.f, 0.f}, s1 = s0;
                if (rot && fq < 2) { const f32x4* rp = (const f32x4*)(rope + (size_t)row * 16); c0 = rp[0]; c1 = rp[1]; s0 = rp[2] * sgn; s1 = rp[3] * sgn; }
#pragma unroll
                for (int bj = 0; bj < 2; ++bj) { f32x4 v0 = acc[ai][bj][m][0], v1 = acc[ai][bj][m][1];
                    if (rot) {
                        f32x4 p0, p1;
#pragma unroll
                        for (int j = 0; j < 4; ++j) { p0[j] = __shfl_xor(v0[j], 16); p1[j] = __shfl_xor(v1[j], 16); }
                        v0 = v0 * c0 + p0 * s0; v1 = v1 * c1 + p1 * s1;
                    }
                    v0 = v0 * qsc; v1 = v1 * qsc;
                    u32x4 w; w.x = cvt_pk_bf16(v0[0], v0[1]); w.y = cvt_pk_bf16(v0[2], v0[3]); w.z = cvt_pk_bf16(v1[0], v1[1]); w.w = cvt_pk_bf16(v1[2], v1[3]);
                    *(u32x4*)(rowp + bj * HALF) = w; } }
    }
};

template <class Epi, class Sched, bool ALIGN_EPI = false, bool SP2 = false>
__device__ __forceinline__ void gemm_phase(PG8_LAS unsigned char* lds, const Gemm g, const Sched& S, const Epi& E) {
    int tid_o = threadIdx.x; asm volatile("" : "+v"(tid_o));
    const int tid = tid_o, wid = __builtin_amdgcn_readfirstlane(tid >> 6), lane = tid & 63, wr = wid >> 2, wc = wid & 3, fr = lane & 15, fq = lane >> 4;
    const int K = g.K, nt = K / BK;
    unsigned voffA[2], voffB[2];
#pragma unroll
    for (int i = 0; i < 2; ++i) { int R, C; stage_rc(tid * 16 + i * 8192, R, C); const int Rb = Epi::PERM ? ((R & ~31) + perm32(R & 31)) : R;
        voffA[i] = g.ablk ? (unsigned)(((C >> 5) * 256 + R) * 64 + (C & 31) * 2) : (unsigned)(R * K + C) * 2u; voffB[i] = (unsigned)(Rb * K + C) * 2u; }
    const size_t kstep = (size_t)(BK * 2);
    const size_t hstep = (size_t)HALF * K * 2;
    const size_t tstep = 2 * hstep;
    const size_t kstepA = g.ablk ? (size_t)32768 : kstep, hstepA = g.ablk ? (size_t)8192 : hstep;
    const unsigned ldsw = (unsigned)wid * 1024u;
    const int aoff = lds_byte(wr * 64 + fr, fq * 8), boff = lds_byte(wc * 32 + fr, fq * 8);
#define PG8_SA(b, h) (((b) * 2 + (h)) * HTB)
#define PG8_SB(b, h) ((4 + (b) * 2 + (h)) * HTB)
#define PG8_STAGE(bufoff, gbase, voff) do { _Pragma("unroll") for (int _i = 0; _i < 2; ++_i) \
        __builtin_amdgcn_global_load_lds((const unsigned*)((const char*)(gbase) + (voff)[_i]), (PG8_LAS unsigned*)(lds + (bufoff) + ldsw + _i * 8192), 16, 0, 0); } while (0)
#define PG8_LDA(dst, b, h) do { _Pragma("unroll") for (int m = 0; m < 4; ++m) _Pragma("unroll") for (int k = 0; k < 2; ++k) dst[m][k] = *(const PG8_LAS bf16x8*)(lds + PG8_SA(b, h) + aoff + m * 2048 + k * 1024); } while (0)
#define PG8_LDB(dst, b, h) do { _Pragma("unroll") for (int n = 0; n < 2; ++n) _Pragma("unroll") for (int k = 0; k < 2; ++k) dst[n][k] = *(const PG8_LAS bf16x8*)(lds + PG8_SB(b, h) + boff + n * 2048 + k * 1024); } while (0)
#define PG8_MMA(ai, bj, At, Bt) do { __builtin_amdgcn_s_setprio(1); _Pragma("unroll") for (int m = 0; m < 4; ++m) _Pragma("unroll") for (int n = 0; n < 2; ++n) _Pragma("unroll") for (int k = 0; k < 2; ++k) \
        acc[ai][bj][m][n] = __builtin_amdgcn_mfma_f32_16x16x32_bf16(Bt[n][k], At[m][k], acc[ai][bj][m][n], 0, 0, 0); __builtin_amdgcn_s_setprio(0); } while (0)
#define PG8_WAIT_V(n) asm volatile("s_waitcnt vmcnt(" #n ")" ::: "memory")
#define PG8_WAIT_L(n) asm volatile("s_waitcnt lgkmcnt(" #n ")" ::: "memory")
#define PG8_BAR __builtin_amdgcn_s_barrier()
#define PG8_SCHED __builtin_amdgcn_sched_barrier(0)
    Unit cur, nxt; int ui = 0;
    if (!S.next(0, cur)) return;
    f32x4 acc[2][2][4][2];
#pragma unroll
    for (int a = 0; a < 2; ++a)
#pragma unroll
        for (int b = 0; b < 2; ++b)
#pragma unroll
            for (int m = 0; m < 4; ++m)
#pragma unroll
                for (int n = 0; n < 2; ++n) acc[a][b][m][n] = (f32x4){0.f, 0.f, 0.f, 0.f};
    bf16x8 At[4][2], B0[2][2], B1[2][2];
    const char* cA = (const char*)g.A + (size_t)cur.pm * tstep; const char* cB = (const char*)g.Bt + (size_t)cur.pn * tstep;
    S.a_ready(cur);
    if constexpr (SP2) {
        PG8_STAGE(PG8_SB(0, 0), cB, voffB); PG8_STAGE(PG8_SB(0, 1), cB + hstep, voffB); PG8_STAGE(PG8_SA(0, 0), cA, voffA); PG8_STAGE(PG8_SA(0, 1), cA + hstepA, voffA);
        if (wr == 1) PG8_BAR;
        PG8_WAIT_V(2); PG8_BAR;
        PG8_STAGE(PG8_SB(1, 0), cB + kstep, voffB); PG8_STAGE(PG8_SA(1, 0), cA + kstepA, voffA); PG8_STAGE(PG8_SB(1, 1), cB + hstep + kstep, voffB);
        PG8_WAIT_V(6); PG8_BAR;
    } else {
        PG8_STAGE(PG8_SB(0, 0), cB, voffB); PG8_STAGE(PG8_SA(0, 0), cA, voffA); PG8_STAGE(PG8_SB(0, 1), cB + hstep, voffB); PG8_STAGE(PG8_SA(0, 1), cA + hstepA, voffA);
        if (wr == 1) PG8_BAR;
        PG8_WAIT_V(4); PG8_BAR;
        PG8_STAGE(PG8_SB(1, 0), cB + kstep, voffB); PG8_STAGE(PG8_SA(1, 0), cA + kstepA, voffA); PG8_STAGE(PG8_SB(1, 1), cB + hstep + kstep, voffB);
        PG8_WAIT_V(6); PG8_BAR;
    }
    for (;;) {
        const bool has_next = S.next(ui + 1, nxt);
        const char* nA = has_next ? (const char*)g.A + (size_t)nxt.pm * tstep : cA; const char* nB = has_next ? (const char*)g.Bt + (size_t)nxt.pn * tstep : cB;
        for (int t = 0; t < nt; t += 2) {
            const bool last = (t == nt - 2);
            const char* a1 = cA + (size_t)(t + 1) * kstepA;
            const char* a2 = last ? nA : cA + (size_t)(t + 2) * kstepA; const char* b2 = last ? nB : cB + (size_t)(t + 2) * kstep;
            const char* a3 = a2 + kstepA; const char* b3 = b2 + kstep;
            if (last && has_next) S.a_ready(nxt);
            if constexpr (SP2) {
            PG8_LDB(B0, 0, 0); PG8_LDB(B1, 0, 1); PG8_SCHED; PG8_LDA(At, 0, 0); PG8_STAGE(PG8_SA(1, 1), a1 + hstepA, voffA);
            PG8_WAIT_V(8); PG8_WAIT_L(0); PG8_BAR; PG8_MMA(0, 0, At, B0); PG8_MMA(0, 1, At, B1); PG8_BAR; PG8_SCHED;
            PG8_LDA(At, 0, 1); PG8_STAGE(PG8_SB(0, 0), b2, voffB); PG8_STAGE(PG8_SB(0, 1), b2 + hstep, voffB); PG8_STAGE(PG8_SA(0, 0), a2, voffA);
            PG8_WAIT_V(8); PG8_WAIT_L(0); PG8_BAR; PG8_MMA(1, 0, At, B0); PG8_MMA(1, 1, At, B1); PG8_BAR; PG8_SCHED;
            PG8_LDB(B0, 1, 0); PG8_LDB(B1, 1, 1); PG8_SCHED; PG8_LDA(At, 1, 0); PG8_STAGE(PG8_SA(0, 1), a2 + hstepA, voffA);
            PG8_WAIT_V(8); PG8_WAIT_L(0); PG8_BAR; PG8_MMA(0, 0, At, B0); PG8_MMA(0, 1, At, B1); PG8_BAR; PG8_SCHED;
            PG8_LDA(At, 1, 1); PG8_STAGE(PG8_SB(1, 0), b3, voffB); PG8_STAGE(PG8_SB(1, 1), b3 + hstep, voffB); PG8_STAGE(PG8_SA(1, 0), a3, voffA);
            PG8_WAIT_V(8); PG8_WAIT_L(0); PG8_BAR; PG8_MMA(1, 0, At, B0); PG8_MMA(1, 1, At, B1); PG8_BAR; PG8_SCHED;
            } else {
            PG8_LDB(B0, 0, 0); PG8_SCHED; PG8_LDA(At, 0, 0); PG8_STAGE(PG8_SA(1, 1), a1 + hstepA, voffA);
            PG8_WAIT_L(8); PG8_BAR; PG8_WAIT_L(0); PG8_MMA(0, 0, At, B0); PG8_BAR; PG8_SCHED;
            PG8_LDB(B1, 0, 1); PG8_STAGE(PG8_SB(0, 0), b2, voffB);
            PG8_BAR; PG8_WAIT_L(0); PG8_MMA(0, 1, At, B1); PG8_BAR;
            PG8_LDA(At, 0, 1); PG8_STAGE(PG8_SA(0, 0), a2, voffA);
            PG8_BAR; PG8_WAIT_L(0); PG8_MMA(1, 0, At, B0); PG8_BAR; PG8_SCHED;
            PG8_STAGE(PG8_SB(0, 1), b2 + hstep, voffB);
            PG8_WAIT_V(6); PG8_BAR; PG8_MMA(1, 1, At, B1); PG8_BAR;
            PG8_LDB(B0, 1, 0); PG8_SCHED; PG8_LDA(At, 1, 0); PG8_STAGE(PG8_SA(0, 1), a2 + hstepA, voffA);
            PG8_WAIT_L(8); PG8_BAR; PG8_WAIT_L(0); PG8_MMA(0, 0, At, B0); PG8_BAR; PG8_SCHED;
            PG8_LDB(B1, 1, 1); PG8_STAGE(PG8_SB(1, 0), b3, voffB);
            PG8_BAR; PG8_WAIT_L(0); PG8_MMA(0, 1, At, B1); PG8_BAR;
            PG8_LDA(At, 1, 1); PG8_STAGE(PG8_SA(1, 0), a3, voffA);
            PG8_BAR; PG8_WAIT_L(0); PG8_MMA(1, 0, At, B0); PG8_BAR; PG8_SCHED;
            PG8_STAGE(PG8_SB(1, 1), b3 + hstep, voffB);
            PG8_WAIT_V(6); PG8_BAR; PG8_MMA(1, 1, At, B1); PG8_BAR;
            }
        }
        if constexpr (ALIGN_EPI) { if (wr == 0) PG8_BAR; }
        if constexpr (!Epi::AFTER_DRAIN) { E(acc, cur, wr, wc, fr, fq); S.done(cur); }
        if (!has_next) break;
#pragma unroll
        for (int a = 0; a < 2; ++a)
#pragma unroll
            for (int b = 0; b < 2; ++b)
#pragma unroll
                for (int m = 0; m < 4; ++m)
#pragma unroll
                    for (int n = 0; n < 2; ++n) acc[a][b][m][n] = (f32x4){0.f, 0.f, 0.f, 0.f};
        cur = nxt; cA = nA; cB = nB; ++ui;
        if constexpr (ALIGN_EPI) { if (wr == 1) PG8_BAR; }
    }
    PG8_WAIT_V(0);
    if constexpr (!ALIGN_EPI) { if (wr == 0) PG8_BAR; }
    PG8_BAR;
    if constexpr (Epi::AFTER_DRAIN) { E.fused(acc, cur, wr, wc, fr, fq, lds, wid, lane); S.done(cur); }
#undef PG8_SA
#undef PG8_SB
#undef PG8_STAGE
#undef PG8_LDA
#undef PG8_LDB
#undef PG8_MMA
#undef PG8_WAIT_V
#undef PG8_WAIT_L
#undef PG8_BAR
#undef PG8_SCHED
}
}
#include <hip/hip_bf16.h>
#include <cmath>
namespace attn_body {
using bf16=__hip_bfloat16;
using bf16x8=__attribute__((ext_vector_type(8)))short;
using s16x4=__attribute__((ext_vector_type(4)))short;
using f32x16=__attribute__((ext_vector_type(16)))float;
using u32x4=__attribute__((ext_vector_type(4)))unsigned;
using f32x4_t=__attribute__((ext_vector_type(4)))float;
constexpr int BATCH=32,NHEAD=8,SEQ=2048,D=64,DM=512;
constexpr int NW=8,QBLK=32,QB=QBLK*NW,KVBLK=64,NQB=SEQ/QB;
constexpr int ATTN_PITCH=DM, ATTN_UNIT_ROWS=QB;
__device__ __forceinline__ int crow(int r,int hi){return (r&3)+8*(r>>2)+4*hi;}
#define SBAR() __builtin_amdgcn_sched_barrier(0)
__device__ __forceinline__ void cmask(f32x16&p0,f32x16&p1,int jb,int qrel,int hi){
  const float NEG=-INFINITY; int lim=qrel-64*jb-4*hi; asm volatile("":"+v"(lim));
  #pragma unroll
  for(int r=0;r<16;++r){const int c=(r&3)+8*(r>>2); if(c>lim)p0[r]=NEG; if(c+32>lim)p1[r]=NEG;}
}

constexpr int NSLOT=3, SLOTB=8192;
constexpr int LDS_K=0, LDS_V=NSLOT*SLOTB, LDS_WS=2*NSLOT*SLOTB, LDS_OST=LDS_WS+NW*64*4, LDS_KB=LDS_OST+NW*4096, LDS_BYTES=LDS_KB+SEQ*4;
constexpr float C2=0.125f*1.4426950408889634f;
__device__ __forceinline__ void glds16(const void*gsrc,unsigned lds_dst){unsigned keep;
  asm volatile("s_mov_b32 %0, m0\n\ts_mov_b32 m0, %2\n\ts_nop 0\n\tglobal_load_lds_dwordx4 %1, off\n\ts_mov_b32 m0, %0":"=&s"(keep):"v"(gsrc),"s"(lds_dst):"memory");}
__device__ __forceinline__ float max3f(float a,float b,float c){float r;asm("v_max3_f32 %0, %1, %2, %3":"=v"(r):"v"(a),"v"(b),"v"(c));return r;}
__device__ __forceinline__ float max2f(float a,float b){float r;asm("v_max_f32_e32 %0, %1, %2":"=v"(r):"v"(a),"v"(b));return r;}
__device__ __forceinline__ float fadd_s(float a,float b){float r;asm("v_add_f32_e32 %0, %1, %2":"=v"(r):"v"(a),"v"(b));return r;}
__device__ __forceinline__ float fsub_s(float a,float b){float r;asm("v_sub_f32_e32 %0, %1, %2":"=v"(r):"v"(a),"v"(b));return r;}
typedef float f32x2_t __attribute__((ext_vector_type(2))); typedef __bf16 bf16x2_t __attribute__((ext_vector_type(2)));
__device__ __forceinline__ unsigned cvtpk_s(float lo,float hi){f32x2_t v={lo,hi};bf16x2_t b=__builtin_convertvector(v,bf16x2_t);return __builtin_bit_cast(unsigned,b);}
#define WAIT_BAR(N) asm volatile("s_waitcnt vmcnt(" #N ") lgkmcnt(0)\n\ts_barrier":::"memory")

__device__ __forceinline__ void qkt(f32x16&p0,f32x16&p1,const char*Kslot,const bf16x8*qr,const f32x16&c0,const f32x16&c1,int r32,int hi){
  const char*kb=Kslot+hi*1024+r32*16;
  #pragma unroll
  for(int d0=0;d0<4;++d0){
    const bf16x8 b0=*reinterpret_cast<const bf16x8*>(kb+d0*2048);
    const bf16x8 b1=*reinterpret_cast<const bf16x8*>(kb+d0*2048+512);
    if(d0==0){p0=__builtin_amdgcn_mfma_f32_32x32x16_bf16(b0,qr[0],c0,0,0,0);p1=__builtin_amdgcn_mfma_f32_32x32x16_bf16(b1,qr[0],c1,0,0,0);}
    else{p0=__builtin_amdgcn_mfma_f32_32x32x16_bf16(b0,qr[d0],p0,0,0,0);p1=__builtin_amdgcn_mfma_f32_32x32x16_bf16(b1,qr[d0],p1,0,0,0);}}
}
typedef __attribute__((address_space(3))) const char* lds_cptr;
typedef short v4i16_t __attribute__((ext_vector_type(4)));
__device__ __forceinline__ void kload8(bf16x8*kf,lds_cptr kp){
  kf[0]=*(const __attribute__((address_space(3))) bf16x8*)(kp);      kf[1]=*(const __attribute__((address_space(3))) bf16x8*)(kp+512);
  kf[2]=*(const __attribute__((address_space(3))) bf16x8*)(kp+2048); kf[3]=*(const __attribute__((address_space(3))) bf16x8*)(kp+2560);
  kf[4]=*(const __attribute__((address_space(3))) bf16x8*)(kp+4096); kf[5]=*(const __attribute__((address_space(3))) bf16x8*)(kp+4608);
  kf[6]=*(const __attribute__((address_space(3))) bf16x8*)(kp+6144); kf[7]=*(const __attribute__((address_space(3))) bf16x8*)(kp+6656);
}
__device__ __forceinline__ void kload2(bf16x8*kf,lds_cptr kp,int j){ kf[2*j]=*(const __attribute__((address_space(3))) bf16x8*)(kp+j*2048); kf[2*j+1]=*(const __attribute__((address_space(3))) bf16x8*)(kp+j*2048+512); }
__device__ __forceinline__ s16x4 vtr(lds_cptr p){ return __builtin_bit_cast(s16x4,__builtin_amdgcn_ds_read_tr16_b64_v4i16((__attribute__((address_space(3))) v4i16_t*)p)); }
__device__ __forceinline__ float rowmax(const f32x16&p0,const f32x16&p1){
  float a=max3f(p0[0],p0[1],p1[0]),b=max3f(p0[2],p0[3],p1[1]);a=max3f(a,p1[2],p1[3]);
  #pragma unroll
  for(int r=4;r<16;r+=4){a=max3f(a,p0[r],p0[r+1]);b=max3f(b,p0[r+2],p0[r+3]);a=max3f(a,p1[r],p1[r+1]);b=max3f(b,p1[r+2],p1[r+3]);}
  const float m=max2f(a,b);
  auto rr=__builtin_amdgcn_permlane32_swap(__float_as_uint(m),__float_as_uint(m),false,false);
  return max2f(__uint_as_float(rr[0]),__uint_as_float(rr[1]));
}
__device__ __forceinline__ void pv(f32x16*o,int vb,bf16x8 pa0,bf16x8 pa1,bf16x8 pa2,bf16x8 pa3){
  #pragma unroll
  for(int d0=0;d0<2;++d0){s16x4 lo[4],hi[4];
    #pragma unroll
    for(int ks=0;ks<4;++ks){
      asm volatile("ds_read_b64_tr_b16 %0,%1 offset:%c2":"=&v"(lo[ks]):"v"(vb),"i"(d0*4096+ks*1024):"memory");
      asm volatile("ds_read_b64_tr_b16 %0,%1 offset:%c2":"=&v"(hi[ks]):"v"(vb),"i"(d0*4096+ks*1024+512):"memory");}
    asm volatile("s_waitcnt lgkmcnt(0)":::"memory");SBAR();
    #define PK(k) (bf16x8){lo[k][0],lo[k][1],lo[k][2],lo[k][3],hi[k][0],hi[k][1],hi[k][2],hi[k][3]}
    o[d0]=__builtin_amdgcn_mfma_f32_32x32x16_bf16(pa0,PK(0),o[d0],0,0,0);
    o[d0]=__builtin_amdgcn_mfma_f32_32x32x16_bf16(pa1,PK(1),o[d0],0,0,0);
    o[d0]=__builtin_amdgcn_mfma_f32_32x32x16_bf16(pa2,PK(2),o[d0],0,0,0);
    o[d0]=__builtin_amdgcn_mfma_f32_32x32x16_bf16(pa3,PK(3),o[d0],0,0,0);
    #undef PK
  }
}

#ifndef ATTN_STORE16
#define ATTN_STORE16(p,v) (*(u32x4*)(p)=(v))
#endif
template<int THRL> __device__ __forceinline__ void attn_unit(int b,int h,int qb,const bf16*Q,const bf16*__restrict__ K,const bf16*__restrict__ V,bf16*O,char*shm){
  int tid_o=threadIdx.x; asm volatile("":"+v"(tid_o));
  const int tid=tid_o,lane=tid&63,r32=lane&31,hi=lane>>5; const int wid=__builtin_amdgcn_readfirstlane(tid>>6);
  const long rowbase=(long)b*SEQ; const int q0=qb*QB;
  const bf16*Qw=Q+(rowbase+q0+wid*QBLK)*DM+h*D;
  const bf16*Kh=K+rowbase*DM+h*D,*Vh=V+rowbase*DM+h*D;
  const unsigned lds0=(unsigned)(uintptr_t)shm;
  float*wsf=(float*)(shm+LDS_WS)+wid*64;
  const bf16*ksrc=Kh+(long)(lane+q0+QB-KVBLK)*DM+wid*8;
  const bf16*vsrc=Vh+(long)(16*(wid&3)+(lane>>2)+q0+QB-KVBLK)*DM+(wid>>2)*32+(lane&3)*8;
  const unsigned kdst=lds0+LDS_K+wid*1024, vdst=lds0+LDS_V+wid*1024;
  #define DMA_K(t,slot) glds16(ksrc-(long)(t)*KVBLK*DM,(unsigned)__builtin_amdgcn_readfirstlane(kdst+(slot)))
  #define DMA_V(t,slot) glds16(vsrc-(long)(t)*KVBLK*DM,(unsigned)__builtin_amdgcn_readfirstlane(vdst+(slot)))
  const int vb0=(int)(lds0+LDS_V)+((lane>>4)&1)*32+(lane&3)*8+(4*hi+((lane&15)>>2))*64;
  const char*Kbase=shm+LDS_K; bf16x8 kf[8];
  const lds_cptr shm3=(lds_cptr)shm; const lds_cptr kp0=shm3+LDS_K+hi*1024+r32*16; const lds_cptr vp0=shm3+LDS_V+((lane>>4)&1)*32+(lane&3)*8+(4*hi+((lane&15)>>2))*64;
  const int NT=(q0+QB)/KVBLK;
  DMA_K(0,0);DMA_V(0,0);DMA_K(1,SLOTB);
  bf16x8 qr[4];
  #pragma unroll
  for(int d0=0;d0<4;++d0)qr[d0]=*reinterpret_cast<const bf16x8*>(&Qw[(long)r32*DM+d0*16+hi*8]);
  float mhat=0.f,l_reg=0.f;f32x16 o[2];o[0]=f32x16{};o[1]=f32x16{};  typedef __attribute__((address_space(3))) const f32x4_t* lds_f4ptr; const lds_f4ptr kbl4=(lds_f4ptr)(shm3+LDS_KB)+hi+(q0+QB-KVBLK)/4;
  #define NB0(t,N0) do{ _Pragma("unroll") for(int g_=0;g_<4;++g_){ const f32x4_t v0_=kbl4[2*g_-16*(t)]; \
      _Pragma("unroll") for(int j_=0;j_<4;++j_){ N0[4*g_+j_]=v0_[j_]-mhat; } } }while(0)
  #define NB1(t,N1) do{ _Pragma("unroll") for(int g_=0;g_<4;++g_){ const f32x4_t v1_=kbl4[8+2*g_-16*(t)]; \
      _Pragma("unroll") for(int j_=0;j_<4;++j_){ N1[4*g_+j_]=v1_[j_]-mhat; } } }while(0)
  const int qrel=wid*QBLK+r32;
  #define CMASK(P0,P1,t) do{int jb_=3-(t); if(jb_>=0)cmask(P0,P1,jb_,qrel,hi);}while(0)
  bool resc=false;
  #define START(P0,P1) do{ const float rm=rowmax(P0,P1); resc=false; \
    { const float dl=(rm==-INFINITY)?0.f:rm; mhat=fadd_s(mhat,dl); \
      _Pragma("unroll") for(int r=0;r<16;++r){P0[r]=fsub_s(P0[r],dl);P1[r]=fsub_s(P1[r],dl);} \
      } \
    _Pragma("unroll") for(int r=0;r<16;++r)P0[r]=__builtin_amdgcn_exp2f(P0[r]); }while(0)
  #define RESC() do{ if(resc){ asm volatile("s_waitcnt lgkmcnt(0)":::"memory"); \
      _Pragma("unroll") for(int d_=0;d_<2;++d_) _Pragma("unroll") for(int r=0;r<16;++r)o[d_][r]*=wsf[crow(r,hi)]; } }while(0)
  f32x16 pA0,pA1,pB0,pB1;
  int sl_prev=0,sl_cur=0,sl_next=SLOTB;
  #define ROT() do{sl_prev=sl_cur;sl_cur=sl_next;sl_next=(sl_next==(NSLOT-1)*SLOTB)?0:sl_next+SLOTB;}while(0)
  DMA_K(2,2*SLOTB);
  WAIT_BAR(3);
  { f32x16 nb0_,nb1_; NB0(0,nb0_); NB1(0,nb1_); qkt(pA0,pA1,Kbase,qr,nb0_,nb1_,r32,hi); }asm volatile("s_nop 15\n\ts_nop 7":"+v"(pA0),"+v"(pA1));CMASK(pA0,pA1,0);
  START(pA0,pA1);
  f32x16 nbc; NB0(1,nbc);
  _Pragma("unroll") for(int r=0;r<16;++r)pA1[r]=__builtin_amdgcn_exp2f(pA1[r]);
  WAIT_BAR(0);
  DMA_K(3,0);DMA_V(1,SLOTB);
  ROT();
  kload8(kf,kp0+sl_cur);
  WAIT_BAR(2);
  s16x4 vlo[8],vhi[8]; u32x4 pw0,pw1,pw2,pw3;
  #define PKW(P,B) cvtpk_s(P[B],P[B+1])
  #define PAF(k) __builtin_bit_cast(bf16x8,pw##k)
  #define VFR(i) (bf16x8){vlo[i][0],vlo[i][1],vlo[i][2],vlo[i][3],vhi[i][0],vhi[i][1],vhi[i][2],vhi[i][3]}
  #define PIN(x) asm volatile("":"+v"(x))
  #define MX3(a,b,c) __builtin_fmaxf(__builtin_fmaxf((a),(b)),(c))
  #define GAPA(MF,A0,A1,A2,A3,W0,W1,PW) do{ MF; sacc+=A0; sacc+=A1; sacc+=A2; sacc+=A3; PIN(sacc); W0; W1; PIN(PW); SBAR(); }while(0)
  #define EX(v) __builtin_amdgcn_exp2f(v)
  #define GAPB(MF,X,B) do{ MF; X[B]=EX(X[B]); X[B+1]=EX(X[B+1]); X[B+2]=EX(X[B+2]); X[B+3]=EX(X[B+3]); PIN(X); SBAR(); }while(0)
  #define VRD(i) do{ vlo[i]=vtr(vp_+(((i)>>2)*4096+((i)&3)*1024)); vhi[i]=vtr(vp_+(((i)>>2)*4096+((i)&3)*1024+512)); }while(0)
  #define KRD(G,j) do{ if(G){ kload2(kf,kp0+sl_next,j); SBAR(); } }while(0)
  #define STEP(C0,C1,P0,P1,t,GK,GV,GL) do{ SBAR(); f32x16 nb1_; \
    const lds_cptr vp_=vp0+sl_prev; \
    VRD(0); SBAR(); float sacc=(P0[0]+P0[1]); \
    GAPA(C0=__builtin_amdgcn_mfma_f32_32x32x16_bf16(kf[0],qr[0],nbc,0,0,0), P0[2],P0[3],P0[4],P0[5],     pw0[0]=PKW(P0,0), pw0[1]=PKW(P0,2), pw0); \
    NB1(t,nb1_); VRD(4); SBAR(); GAPA(C1=__builtin_amdgcn_mfma_f32_32x32x16_bf16(kf[1],qr[0],nb1_,0,0,0), P0[6],P0[7],P0[8],P0[9],     pw0[2]=PKW(P0,4), pw0[3]=PKW(P0,6), pw0); \
    VRD(1); SBAR(); GAPA(C0=__builtin_amdgcn_mfma_f32_32x32x16_bf16(kf[2],qr[1],C0,0,0,0),   P0[10],P0[11],P0[12],P0[13], pw1[0]=PKW(P0,8), pw1[1]=PKW(P0,10), pw1); \
    VRD(5); SBAR(); GAPA(C1=__builtin_amdgcn_mfma_f32_32x32x16_bf16(kf[3],qr[1],C1,0,0,0),   P0[14],P0[15],P1[0],P1[1],   pw1[2]=PKW(P0,12),pw1[3]=PKW(P0,14), pw1); \
    VRD(2); SBAR(); GAPA(C0=__builtin_amdgcn_mfma_f32_32x32x16_bf16(kf[4],qr[2],C0,0,0,0),   P1[2],P1[3],P1[4],P1[5],     pw2[0]=PKW(P1,0), pw2[1]=PKW(P1,2), pw2); \
    VRD(6); SBAR(); GAPA(C1=__builtin_amdgcn_mfma_f32_32x32x16_bf16(kf[5],qr[2],C1,0,0,0),   P1[6],P1[7],P1[8],P1[9],     pw2[2]=PKW(P1,4), pw2[3]=PKW(P1,6), pw2); \
    VRD(3); SBAR(); GAPA(C0=__builtin_amdgcn_mfma_f32_32x32x16_bf16(kf[6],qr[3],C0,0,0,0),   P1[10],P1[11],P1[12],P1[13], pw3[0]=PKW(P1,8), pw3[1]=PKW(P1,10), pw3); \
    VRD(7); SBAR(); GAPA(C1=__builtin_amdgcn_mfma_f32_32x32x16_bf16(kf[7],qr[3],C1,0,0,0),   P1[14],P1[15],0.f,0.f,       pw3[2]=PKW(P1,12),pw3[3]=PKW(P1,14), pw3); \
    l_reg+=sacc; \
    if(GK){DMA_K((t)+3,sl_cur);} if(GV){DMA_V((t)+1,sl_next);} \
    CMASK(C0,C1,t); \
    { float a=MX3(C0[0],C0[1],C1[0]),b=MX3(C0[2],C0[3],C1[1]); a=MX3(a,C1[2],C1[3]); \
      _Pragma("unroll") for(int r=4;r<16;r+=4){a=MX3(a,C0[r],C0[r+1]);b=MX3(b,C0[r+2],C0[r+3]);a=MX3(a,C1[r],C1[r+1]);b=MX3(b,C1[r+2],C1[r+3]);} \
      float rm=__builtin_fmaxf(a,b); { auto rr=__builtin_amdgcn_permlane32_swap(__float_as_uint(rm),__float_as_uint(rm),false,false); rm=__builtin_fmaxf(__uint_as_float(rr[0]),__uint_as_float(rr[1])); } \
      resc=false; \
      if(__builtin_expect(__any(rm>(float)THRL),0)){ const float dl=__builtin_fmaxf(rm,0.f); mhat+=dl; \
        _Pragma("unroll") for(int r=0;r<16;++r){C0[r]-=dl;C1[r]-=dl;} \
        const float f=__builtin_amdgcn_exp2f(-dl); l_reg*=f; if(hi==0)wsf[r32]=f; resc=true; } } \
    SBAR(); \
    GAPB(o[0]=__builtin_amdgcn_mfma_f32_32x32x16_bf16(PAF(0),VFR(0),o[0],0,0,0), C0,0); \
    GAPB(o[1]=__builtin_amdgcn_mfma_f32_32x32x16_bf16(PAF(0),VFR(4),o[1],0,0,0), C0,4); \
    KRD(GL,0); GAPB(o[0]=__builtin_amdgcn_mfma_f32_32x32x16_bf16(PAF(1),VFR(1),o[0],0,0,0), C0,8); \
    KRD(GL,1); GAPB(o[1]=__builtin_amdgcn_mfma_f32_32x32x16_bf16(PAF(1),VFR(5),o[1],0,0,0), C0,12); \
    KRD(GL,2); GAPB(o[0]=__builtin_amdgcn_mfma_f32_32x32x16_bf16(PAF(2),VFR(2),o[0],0,0,0), C1,0); \
    KRD(GL,3); GAPB(o[1]=__builtin_amdgcn_mfma_f32_32x32x16_bf16(PAF(2),VFR(6),o[1],0,0,0), C1,4); \
    GAPB(o[0]=__builtin_amdgcn_mfma_f32_32x32x16_bf16(PAF(3),VFR(3),o[0],0,0,0), C1,8); \
    GAPB(o[1]=__builtin_amdgcn_mfma_f32_32x32x16_bf16(PAF(3),VFR(7),o[1],0,0,0), C1,12); \
    if(GL){ NB0((t)+1,nbc); } \
    }while(0)
  int t=1;
  for(;t+5<NT;t+=2){
    STEP(pB0,pB1,pA0,pA1,t,true,true,true);     WAIT_BAR(2); RESC(); ROT();
    STEP(pA0,pA1,pB0,pB1,t+1,true,true,true);   WAIT_BAR(2); RESC(); ROT();
  }
  #undef CMASK
  #define CMASK(P0,P1,t) do{int jb_=3-(t); if(jb_>=0)cmask(P0,P1,jb_,qrel,hi);}while(0)
  #define ENDW(tt) do{ if((tt)+3<NT){WAIT_BAR(2);} else if((tt)+2<NT){WAIT_BAR(1);} else {WAIT_BAR(0);} }while(0)
  for(;t+1<NT;t+=2){
    STEP(pB0,pB1,pA0,pA1,t,(t+3<NT),(t+1<NT),(t+1<NT));       ENDW(t);   RESC(); ROT();
    STEP(pA0,pA1,pB0,pB1,t+1,(t+4<NT),(t+2<NT),(t+2<NT));     ENDW(t+1); RESC(); ROT();
  }
  STEP(pB0,pB1,pA0,pA1,NT-1,false,false,false); RESC();
  { float sacc=pB0[0]+pB0[1]; _Pragma("unroll") for(int r=2;r<16;++r)sacc+=pB0[r]; _Pragma("unroll") for(int r=0;r<16;++r)sacc+=pB1[r]; l_reg+=sacc;
    pw0=(u32x4){PKW(pB0,0),PKW(pB0,2),PKW(pB0,4),PKW(pB0,6)};pw1=(u32x4){PKW(pB0,8),PKW(pB0,10),PKW(pB0,12),PKW(pB0,14)};pw2=(u32x4){PKW(pB1,0),PKW(pB1,2),PKW(pB1,4),PKW(pB1,6)};pw3=(u32x4){PKW(pB1,8),PKW(pB1,10),PKW(pB1,12),PKW(pB1,14)};
    SBAR(); pv(o,vb0+sl_cur,PAF(0),PAF(1),PAF(2),PAF(3)); }
  #undef PKW
  #undef PAF
  #undef VFR
  #undef PIN
  #undef MX3
  #undef GAPA
  #undef GAPB
  #undef EX
  #undef VRD
  #undef KRD
  #undef STEP
  #undef ENDW
  {auto rr=__builtin_amdgcn_permlane32_swap(__float_as_uint(l_reg),__float_as_uint(l_reg),false,false);l_reg=__uint_as_float(rr[0])+__uint_as_float(rr[1]);}
  if(hi==0)wsf[32+r32]=l_reg;asm volatile("s_waitcnt lgkmcnt(0)":::"memory");
  float rli[16];
  #pragma unroll
  for(int r=0;r<16;++r)rli[r]=__builtin_amdgcn_rcpf(wsf[32+crow(r,hi)]);
  bf16*Ow=O+(rowbase+q0+wid*QBLK)*DM+h*D;
  { bf16*stg=(bf16*)(shm+LDS_OST)+wid*2048;
    #pragma unroll
    for(int r=0;r<16;++r){const int orow=crow(r,hi);
      #pragma unroll
      for(int d0=0;d0<2;++d0)stg[orow*64+d0*32+r32]=__float2bfloat16(o[d0][r]*rli[r]);}
    asm volatile("s_waitcnt lgkmcnt(0)":::"memory");
    #pragma unroll
    for(int i=0;i<4;++i){const int row=i*8+(lane>>3),ch=lane&7; const u32x4 v=*(const u32x4*)(stg+row*64+ch*8); ATTN_STORE16(Ow+(long)row*DM+ch*8,v);} }
  asm volatile("s_waitcnt lgkmcnt(0)\n\ts_barrier":::"memory");
  #undef DMA_K
  #undef DMA_V
  #undef NB0
  #undef NB1
  #undef CMASK
  #undef START
  #undef RESC
  #undef ROT
}
constexpr int ATTN_LDS_BYTES=LDS_BYTES;
#undef SBAR
#undef WAIT_BAR
}

#define LAS __attribute__((address_space(3)))
typedef unsigned short bf16_t;
typedef short bf16x8 __attribute__((ext_vector_type(8)));
typedef short s16x4 __attribute__((ext_vector_type(4)));
typedef float f32x4 __attribute__((ext_vector_type(4)));
typedef float f32x16 __attribute__((ext_vector_type(16)));
typedef unsigned u32x4 __attribute__((ext_vector_type(4)));
typedef unsigned u32x2 __attribute__((ext_vector_type(2)));

constexpr int DM = 1024, NBATCH = 32, SEQ = 2048, T = NBATCH * SEQ, DFF = 2752, DFFP = 2816, INCOLS = 3080, NMODC = 9 * DM;
constexpr int NWAVES = 8, NTHR = 512;
constexpr float EPS = 1e-6f, LOG2E = 1.4426950408889634f;
constexpr size_t MiB = 1u << 20;
constexpr size_t WS_WGU1 = 0, WS_WD1 = 11 * MiB, WS_WGU2 = 17 * MiB, WS_WD2 = 28 * MiB, WS_WIN = 34 * MiB, WS_WOUT = 40 * MiB, WS_MOD = 42 * MiB,
                 WS_ROPE = 44 * MiB, WS_FL = 48 * MiB, WS_KB = 50 * MiB, WS_LSE = 52 * MiB, WS_WF = 58 * MiB, WS_BAR = 59 * MiB,
                 WS_H = 64 * MiB, WS_Y = 192 * MiB, WS_BIG = 320 * MiB, WS_OA = 704 * MiB, WS_OB = 896 * MiB, WS_END = 960 * MiB;
constexpr size_t QKV_STRIDE = (size_t)T * 512;
constexpr int LDS_BYTES = 151552;

__device__ __forceinline__ float wave_sum(float v) {
#pragma unroll
    for (int o = 1; o < 64; o <<= 1) v += __shfl_xor(v, o);
    return v;
}
__device__ __forceinline__ unsigned pk2(float lo, float hi) { return pg8::cvt_pk_bf16(lo, hi); }
__device__ __forceinline__ float bf_lo(unsigned u) { return __uint_as_float(u << 16); }
__device__ __forceinline__ float bf_hi(unsigned u) { return __uint_as_float(u & 0xffff0000u); }
#define LDS_WAIT() asm volatile("s_waitcnt lgkmcnt(0)" ::: "memory")

__device__ __forceinline__ int opaque_tid() { int t = threadIdx.x; asm volatile("" : "+v"(t)); return t; }
__device__ __forceinline__ void tr_item(const float* __restrict__ W, int ldn, int k0, int n0, bf16_t* WT, int Kd, int drow0, LAS float* scr, int lane) {
#pragma unroll 8
    for (int i = 0; i < 32; ++i) { const int kk = 2 * i + (lane >> 5); scr[kk * 33 + (lane & 31)] = W[(size_t)(k0 + kk) * ldn + n0 + (lane & 31)]; }
    LDS_WAIT();
    const int c = lane & 7;
#pragma unroll
    for (int j = 0; j < 4; ++j) { const int n = (lane >> 3) + 8 * j; const LAS float* s = scr + (8 * c) * 33 + n;
        u32x4 o; o.x = pk2(s[0 * 33], s[1 * 33]); o.y = pk2(s[2 * 33], s[3 * 33]); o.z = pk2(s[4 * 33], s[5 * 33]); o.w = pk2(s[6 * 33], s[7 * 33]);
        *(u32x4*)(WT + (size_t)(drow0 + n) * Kd + k0 + 8 * c) = o; }
    LDS_WAIT();
}

struct Args { const float* in[22]; float* out; unsigned char* ws; };

__device__ __forceinline__ void p0_phase(const Args& a, LAS unsigned char* lds, int tid, int lane, int wave) {
    unsigned char* ws = a.ws;
    const int G = gridDim.x;
    {
        LAS float* sc = (LAS float*)lds;
        const float* c = a.in[1]; const float* wada = a.in[3]; const float* bada = a.in[4]; float* MOD = (float*)(ws + WS_MOD);
        for (int it = blockIdx.x; it < NMODC / 64; it += G) {
            __syncthreads();
            for (int e = tid; e < NBATCH * DM; e += NTHR) { const float v = c[e]; sc[e] = v / (1.0f + __expf(-v)); }
            __syncthreads();
            const int j = it * 64 + lane; const int kb = wave * 128;
            float acc[32];
#pragma unroll
            for (int b = 0; b < 32; ++b) acc[b] = 0.f;
            for (int k4 = 0; k4 < 128; k4 += 4) {
                const float w0 = wada[(size_t)(kb + k4 + 0) * NMODC + j], w1 = wada[(size_t)(kb + k4 + 1) * NMODC + j],
                            w2 = wada[(size_t)(kb + k4 + 2) * NMODC + j], w3 = wada[(size_t)(kb + k4 + 3) * NMODC + j];
#pragma unroll
                for (int b = 0; b < 32; ++b) { const f32x4 s = *(const LAS f32x4*)(sc + b * DM + kb + k4); acc[b] += s[0] * w0 + s[1] * w1 + s[2] * w2 + s[3] * w3; }
            }
            __syncthreads();
            LAS float* P = (LAS float*)lds;
#pragma unroll
            for (int b = 0; b < 32; ++b) P[(wave * 32 + b) * 64 + lane] = acc[b];
            __syncthreads();
            for (int o = tid; o < 32 * 64; o += NTHR) { const int b = o >> 6, col = o & 63; float s = 0.f;
#pragma unroll
                for (int w = 0; w < 8; ++w) s += P[(w * 32 + b) * 64 + col];
                MOD[(size_t)b * NMODC + it * 64 + col] = s + bada[it * 64 + col]; }
        }
        __syncthreads();
    }
    {
        LAS float* scr = (LAS float*)(lds + wave * 16384);
        const int gw = blockIdx.x * NWAVES + wave, NGW = G * NWAVES;
        constexpr int I_G = 16 * 86, I_D = 43 * 32, I_IN = 16 * 96, I_O = 16 * 32;
        constexpr int NITEMS = 2 * (2 * I_G + I_D) + I_IN + I_O;
        for (int it = gw; it < NITEMS; it += NGW) {
            int r = it; bool done = false;
#pragma unroll
            for (int f = 0; f < 2; ++f) {
                if (done) break;
                const float* Wg = a.in[f ? 19 : 7]; const float* Wu = a.in[f ? 20 : 8]; const float* Wd = a.in[f ? 21 : 9];
                bf16_t* WGU = (bf16_t*)(ws + (f ? WS_WGU2 : WS_WGU1)); bf16_t* WD = (bf16_t*)(ws + (f ? WS_WD2 : WS_WD1));
                if (r < 2 * I_G) { const int up = r >= I_G; const int q = up ? r - I_G : r; const int kb = q / 86, nb = q % 86, n0 = 32 * nb;
                    tr_item(up ? Wu : Wg, DFF, 64 * kb, n0, WGU, DM, 256 * (n0 >> 7) + (n0 & 127) + (up ? 128 : 0), scr, lane); done = true; continue; }
                r -= 2 * I_G;
                if (r < I_D) { const int kb = r / 32, nb = r % 32; tr_item(Wd, DM, 64 * kb, 32 * nb, WD, DFFP, 32 * nb, scr, lane); done = true; continue; }
                r -= I_D;
            }
            if (done) continue;
            if (r < I_IN) { const int kb = r / 96, nb = r % 96; tr_item(a.in[12], INCOLS, 64 * kb, 32 * nb, (bf16_t*)(ws + WS_WIN), DM, 32 * nb, scr, lane); continue; }
            r -= I_IN;
            { const int kb = r / 32, nb = r % 32; tr_item(a.in[16], DM, 64 * kb, 32 * nb, (bf16_t*)(ws + WS_WOUT), DM, 32 * nb, scr, lane); }
        }
    }
    {
        const int gt = blockIdx.x * NTHR + tid, NT = G * NTHR;
        for (int e = gt; e < 2 * 128 * 128; e += NT) { const int f = e >> 14, q = e & 16383, rr = q >> 7, ch = q & 127;
            bf16_t* WGU = (bf16_t*)(ws + (f ? WS_WGU2 : WS_WGU1)); const int row = 21 * 256 + (rr < 64 ? 64 + rr : 128 + rr);
            *(u32x4*)(WGU + (size_t)row * DM + ch * 8) = (u32x4){0u, 0u, 0u, 0u}; }
        for (int e = gt; e < 2 * 1024 * 8; e += NT) { const int f = e >> 13, q = e & 8191, row = q >> 3, ch = q & 7;
            bf16_t* WD = (bf16_t*)(ws + (f ? WS_WD2 : WS_WD1)); *(u32x4*)(WD + (size_t)row * DFFP + DFF + ch * 8) = (u32x4){0u, 0u, 0u, 0u}; }
        float* WF = (float*)(ws + WS_WF);
        for (int e = gt; e < 8 * DM; e += NT) { const int j = e >> 10, k = e & 1023; WF[e] = a.in[12][(size_t)k * INCOLS + 3072 + j]; }
        float* ROPE = (float*)(ws + WS_ROPE); const int* pos = (const int*)a.in[2];
        for (int e = gt; e < T * 8; e += NT) { const int row = e >> 3, i = e & 7; const float inv = exp2f(-(float)i * 0.125f * 18.931568569324174f);
            const float ang = (float)pos[row] * inv; ROPE[(size_t)row * 16 + i] = cosf(ang); ROPE[(size_t)row * 16 + 8 + i] = sinf(ang); }
    }
}

template <bool HAS_Y, bool HAS_H, bool HAS_FL>
__device__ __forceinline__ void rowpass(const float* xin, float* xout, const bf16_t* Y, bf16_t* H, float* FL, const float* g_post, const float* g_pre,
                                        const float* MOD, int gi, float gscale, int sci, int shi, LAS const float* wfl, int lane, int wave, int b0, int nbat) {
    constexpr int R = 4;
    const int gw = blockIdx.x * NWAVES + wave, NGW = gridDim.x * NWAVES;
    const int WPB = (NGW / nbat) > 0 ? (NGW / nbat) : 1; const int wb = b0 + gw / WPB, wj = gw % WPB;
    int cur_b = -1;
    f32x4 A[4], Bv[4], Cv[4];
#pragma unroll
    for (int j = 0; j < 4; ++j) { A[j] = (f32x4){0.f, 0.f, 0.f, 0.f}; Bv[j] = A[j]; Cv[j] = A[j]; }
    for (int lr = wj * R; lr < SEQ && wb < b0 + nbat; lr += WPB * R) {
        const int row0 = wb * SEQ + lr;
        const int b = wb;
        if (b != cur_b) { cur_b = b;
#pragma unroll
            for (int j = 0; j < 4; ++j) { const int c = 4 * lane + 256 * j;
                if (HAS_Y) A[j] = *(const f32x4*)(MOD + (size_t)b * NMODC + gi * DM + c) * *(const f32x4*)(g_post + c) * gscale;
                if (HAS_H) { Bv[j] = *(const f32x4*)(g_pre + c) * (*(const f32x4*)(MOD + (size_t)b * NMODC + sci * DM + c) + 1.0f); Cv[j] = *(const f32x4*)(MOD + (size_t)b * NMODC + shi * DM + c); } } }
        f32x4 x[R][4]; u32x2 yw[R][4];
#pragma unroll
        for (int q = 0; q < R; ++q)
#pragma unroll
            for (int j = 0; j < 4; ++j) { x[q][j] = __builtin_nontemporal_load((const f32x4*)(xin + (size_t)(row0 + q) * DM + 4 * lane + 256 * j));
                if (HAS_Y) yw[q][j] = __builtin_nontemporal_load((const u32x2*)(Y + (size_t)(row0 + q) * DM + 4 * lane + 256 * j)); }
        if (HAS_Y) {
            float ss[R];
#pragma unroll
            for (int q = 0; q < R; ++q) { ss[q] = 0.f;
#pragma unroll
                for (int j = 0; j < 4; ++j) { const float y0 = bf_lo(yw[q][j].x), y1 = bf_hi(yw[q][j].x), y2 = bf_lo(yw[q][j].y), y3 = bf_hi(yw[q][j].y); ss[q] += (y0 * y0 + y1 * y1) + (y2 * y2 + y3 * y3); } }
#pragma unroll
            for (int o = 1; o < 64; o <<= 1)
#pragma unroll
                for (int q = 0; q < R; ++q) ss[q] += __shfl_xor(ss[q], o);
#pragma unroll
            for (int q = 0; q < R; ++q) { const float rstd = 1.0f / sqrtf(ss[q] * (1.0f / DM) + EPS);
#pragma unroll
                for (int j = 0; j < 4; ++j) { const f32x4 y = {bf_lo(yw[q][j].x), bf_hi(yw[q][j].x), bf_lo(yw[q][j].y), bf_hi(yw[q][j].y)};
                    x[q][j] = x[q][j] + A[j] * (y * rstd); __builtin_nontemporal_store(x[q][j], (f32x4*)(xout + (size_t)(row0 + q) * DM + 4 * lane + 256 * j)); } }
        }
        if (HAS_H) {
            float ss[R];
#pragma unroll
            for (int q = 0; q < R; ++q) { ss[q] = 0.f;
#pragma unroll
                for (int j = 0; j < 4; ++j) ss[q] += (x[q][j][0] * x[q][j][0] + x[q][j][1] * x[q][j][1]) + (x[q][j][2] * x[q][j][2] + x[q][j][3] * x[q][j][3]); }
#pragma unroll
            for (int o = 1; o < 64; o <<= 1)
#pragma unroll
                for (int q = 0; q < R; ++q) ss[q] += __shfl_xor(ss[q], o);
#pragma unroll
            for (int q = 0; q < R; ++q) { const float rstd = 1.0f / sqrtf(ss[q] * (1.0f / DM) + EPS);
                f32x4 h[4];
#pragma unroll
                for (int j = 0; j < 4; ++j) { h[j] = (x[q][j] * rstd) * Bv[j] + Cv[j];
                    u32x2 w; w.x = pk2(h[j][0], h[j][1]); w.y = pk2(h[j][2], h[j][3]); *(u32x2*)(H + (size_t)(row0 + q) * DM + 4 * lane + 256 * j) = w; }
                if (HAS_FL) {
                    float myv = 0.f;
#pragma unroll
                    for (int f = 0; f < 8; ++f) { float d = 0.f;
#pragma unroll
                        for (int j = 0; j < 4; ++j) { const f32x4 wv = *(const LAS f32x4*)(wfl + f * DM + 4 * lane + 256 * j); d += (h[j][0] * wv[0] + h[j][1] * wv[1]) + (h[j][2] * wv[2] + h[j][3] * wv[3]); }
                        d = wave_sum(d); if (lane == f) myv = d; }
                    if (lane < 8) FL[(size_t)(row0 + q) * 8 + lane] = myv;
                }
            }
        }
    }
}

namespace att {
constexpr int KP = 144;
constexpr float C2 = 0.125f * 1.4426950408889634f;
#define MFMA32(a, b, c) __builtin_amdgcn_mfma_f32_32x32x16_bf16((a), (b), (c), 0, 0, 0)
__device__ __forceinline__ s16x4 vtr(LAS const unsigned char* p) { return __builtin_bit_cast(s16x4, __builtin_amdgcn_ds_read_tr16_b64_v4i16((LAS s16x4*)p)); }
__device__ __forceinline__ bf16x8 pack8(const f32x16& x, int s) {
    u32x4 p; p.x = pk2(x[8 * s + 0], x[8 * s + 1]); p.y = pk2(x[8 * s + 2], x[8 * s + 3]); p.z = pk2(x[8 * s + 4], x[8 * s + 5]); p.w = pk2(x[8 * s + 6], x[8 * s + 7]);
    return __builtin_bit_cast(bf16x8, p);
}
template <int NKB, bool M0, bool M1, bool BIAS>
__device__ __forceinline__ void step(LAS const unsigned char* kbuf, LAS const unsigned char* vbuf, LAS const float* kbias, const bf16x8 (&qf)[4], f32x16 (&o)[2], float& m, float& l,
                                     int lo0, int hi0, int lo1, int hi1, int r, int h, int lane) {
    f32x16 s[NKB];
#pragma unroll
    for (int kb = 0; kb < NKB; ++kb) {
#pragma unroll
        for (int i = 0; i < 16; ++i) s[kb][i] = 0.f;
#pragma unroll
        for (int ss = 0; ss < 4; ++ss) { const bf16x8 kf = *(const LAS bf16x8*)(kbuf + (32 * kb + r) * KP + 32 * ss + 16 * h); s[kb] = MFMA32(kf, qf[ss], s[kb]); }
    }
    float mx = -INFINITY;
#pragma unroll
    for (int kb = 0; kb < NKB; ++kb) {
        const bool MK = kb == 0 ? M0 : M1; const int lo = (kb == 0 ? lo0 : lo1) - 4 * h, hi = (kb == 0 ? hi0 : hi1) - 4 * h; const unsigned span = (unsigned)(hi - lo);
#pragma unroll
        for (int g = 0; g < 4; ++g) {
            f32x4 bv = {0.f, 0.f, 0.f, 0.f};
            if (BIAS) bv = *(const LAS f32x4*)(kbias + 32 * kb + 8 * g + 4 * h);
#pragma unroll
            for (int j = 0; j < 4; ++j) { const int i = 4 * g + j; float v = s[kb][i] * C2 + bv[j];
                if (MK) { const int c = j + 8 * g; v = ((unsigned)(c - lo) <= span && hi >= lo) ? v : -INFINITY; }
                s[kb][i] = v; mx = fmaxf(mx, v); }
        }
    }
    mx = fmaxf(mx, __shfl_xor(mx, 32));
    const float mn = fmaxf(m, mx); const float alpha = __builtin_amdgcn_exp2f(m - mn); m = mn;
    float ps = 0.f;
#pragma unroll
    for (int kb = 0; kb < NKB; ++kb)
#pragma unroll
        for (int i = 0; i < 16; ++i) { const float p = __builtin_amdgcn_exp2f(s[kb][i] - mn); s[kb][i] = p; ps += p; }
    l = l * alpha + ps;
#pragma unroll
    for (int i = 0; i < 16; ++i) { o[0][i] *= alpha; o[1][i] *= alpha; }
    const int q4 = (lane & 15) >> 2, p4 = lane & 3, blk = (lane >> 4) & 1;
    LAS const unsigned char* vb = vbuf + (4 * h + q4) * KP + 32 * blk + 8 * p4;
#pragma unroll
    for (int kb = 0; kb < NKB; ++kb)
#pragma unroll
        for (int s2 = 0; s2 < 2; ++s2) { const bf16x8 pf = pack8(s[kb], s2);
#pragma unroll
            for (int db = 0; db < 2; ++db) { const s16x4 a0 = vtr(vb + (32 * kb + 16 * s2) * KP + 64 * db), a1 = vtr(vb + (32 * kb + 16 * s2 + 8) * KP + 64 * db);
                const bf16x8 vf = __builtin_shufflevector(a0, a1, 0, 1, 2, 3, 4, 5, 6, 7); o[db] = MFMA32(vf, pf, o[db]); } }
}
__device__ __forceinline__ float finish(f32x16 (&o)[2], float l, bf16_t* orow, int h) {
    const float lt = l + __shfl_xor(l, 32); const float inv = 1.0f / lt;
#pragma unroll
    for (int db = 0; db < 2; ++db)
#pragma unroll
        for (int g = 0; g < 4; ++g) { u32x2 w; w.x = pk2(o[db][4 * g + 0] * inv, o[db][4 * g + 1] * inv); w.y = pk2(o[db][4 * g + 2] * inv, o[db][4 * g + 3] * inv);
            *(u32x2*)(orow + 32 * db + 8 * g + 4 * h) = w; }
    return lt;
}

__device__ __forceinline__ void a_phase(const bf16_t* Q, const bf16_t* K, const bf16_t* V, bf16_t* OA, float* LSE, LAS unsigned char* lds, int tid, int lane, int wave, int b0, int nbat) {
    const int r = lane & 31, h = lane >> 5, half = wave >> 2, w4 = wave & 3, t256 = tid & 255;
    LAS unsigned char* kbase = lds + half * (2 * 256 * KP); LAS unsigned char* vbase = kbase + 256 * KP;
    for (int it = blockIdx.x; it < nbat * 8 * 24; it += gridDim.x) {
        const int su = b0 * 8 * 48 + 2 * it + half; const int bh = su / 48, u = su % 48, p = u >> 4, v = u & 15, b = bh >> 3, hd = bh & 7;
        const int d = (p == 0) ? 1 : (p == 1 ? 4 : 16); const int cls = (p == 0) ? 0 : (p == 1 ? (v >> 2) : v); const int n = (p == 0) ? v : (p == 1 ? (v & 3) : 0);
        __syncthreads();
#pragma unroll
        for (int bt = 0; bt < 2; ++bt) {
            u32x4 kr[4], vr[4];
#pragma unroll
            for (int i = 0; i < 4; ++i) { const int idx = t256 + 256 * (4 * bt + i); const int j = idx >> 3, ch = idx & 7; const int mk = 128 * n - 128 + j;
                if (mk >= 0) { const size_t row = (size_t)b * SEQ + mk * d + cls; kr[i] = *(const u32x4*)(K + row * 512 + hd * 64 + ch * 8); vr[i] = *(const u32x4*)(V + row * 512 + hd * 64 + ch * 8); }
                else { kr[i] = (u32x4){0u, 0u, 0u, 0u}; vr[i] = kr[i]; } }
#pragma unroll
            for (int i = 0; i < 4; ++i) { const int idx = t256 + 256 * (4 * bt + i); const int j = idx >> 3, ch = idx & 7;
                *(LAS u32x4*)(kbase + j * KP + ch * 16) = kr[i]; *(LAS u32x4*)(vbase + j * KP + ch * 16) = vr[i]; }
        }
        const int mq = 128 * n + 32 * w4 + r; const size_t qrow = (size_t)b * SEQ + mq * d + cls;
        bf16x8 qf[4];
#pragma unroll
        for (int ss = 0; ss < 4; ++ss) qf[ss] = *(const bf16x8*)(Q + qrow * 512 + hd * 64 + 16 * ss + 8 * h);
        __syncthreads();
        f32x16 o[2];
#pragma unroll
        for (int i = 0; i < 16; ++i) { o[0][i] = 0.f; o[1][i] = 0.f; }
        float m = -1e30f, l = 0.f;
        const int jlo = (n == 0) ? max(32 * w4 + r, 128) : 32 * w4 + r, jhi = 128 + 32 * w4 + r;
        LAS const unsigned char* kw = kbase + 32 * w4 * KP; LAS const unsigned char* vw = vbase + 32 * w4 * KP;
        if (n > 0) {
            step<2, true, false, false>(kw, vw, nullptr, qf, o, m, l, r, 31, 0, 31, r, h, lane);
            step<2, false, false, false>(kw + 64 * KP, vw + 64 * KP, nullptr, qf, o, m, l, 0, 0, 0, 0, r, h, lane);
        } else {
            if (w4 + 1 >= 4) step<2, true, true, false>(kw, vw, nullptr, qf, o, m, l, jlo - 32 * w4, jhi - 32 * w4, jlo - 32 * (w4 + 1), jhi - 32 * (w4 + 1), r, h, lane);
            if (w4 + 3 >= 4) step<2, true, true, false>(kw + 64 * KP, vw + 64 * KP, nullptr, qf, o, m, l, jlo - 32 * (w4 + 2), jhi - 32 * (w4 + 2), jlo - 32 * (w4 + 3), jhi - 32 * (w4 + 3), r, h, lane);
        }
        step<1, true, false, false>(kw + 128 * KP, vw + 128 * KP, nullptr, qf, o, m, l, jlo - 32 * (w4 + 4), jhi - 32 * (w4 + 4), 0, 0, r, h, lane);
        const float lt = finish(o, l, OA + ((size_t)p * T + qrow) * 512 + hd * 64, h);
        if (h == 0) LSE[((size_t)p * T + qrow) * 8 + hd] = m + __log2f(lt);
    }
    __syncthreads();
}
}


__device__ __forceinline__ void b_phase2(const bf16_t* Q, const bf16_t* K, const bf16_t* V, const float* KBIAS, bf16_t* O, unsigned char* shm, int tid, int b0, int nbat) {
    for (int it = blockIdx.x; it < nbat * 8 * 2; it += gridDim.x) {
        const int bh = b0 * 8 + (it >> 1), set = it & 1;
        const int t2 = opaque_tid();
        const f32x4 v = *(const f32x4*)(KBIAS + (size_t)bh * SEQ + 4 * t2);
        *(LAS f32x4*)((LAS unsigned char*)shm + attn_body::LDS_KB + 16 * t2) = v;
        __syncthreads();
        for (int k = 0; k < 4; ++k) { const int qb = (k & 1) ? (2 * (k >> 1) + set) : (7 - 2 * (k >> 1) - set);
            attn_body::attn_unit<8>(bh >> 3, bh & 7, qb, (const attn_body::bf16*)Q, (const attn_body::bf16*)K, (const attn_body::bf16*)V, (attn_body::bf16*)O, (char*)shm); }
    }
    __syncthreads();
}

__device__ __forceinline__ void merge_pass(const bf16_t* OA, const float* LSE, const bf16_t* OB, const float* g_a, const float* g_b, bf16_t* MG, int lane, int wave, int r0, int nrows) {
    constexpr int R = 4;
    const int gw = blockIdx.x * NWAVES + wave, NGW = gridDim.x * NWAVES;
    f32x4 ga0 = *(const f32x4*)(g_a + 8 * lane), ga1 = *(const f32x4*)(g_a + 8 * lane + 4), gb0 = *(const f32x4*)(g_b + 8 * lane), gb1 = *(const f32x4*)(g_b + 8 * lane + 4);
    const int hd = lane >> 3;
    for (int rowb = r0 + gw * R; rowb < r0 + nrows; rowb += NGW * R) {
        float ls[R][3]; u32x4 w[R][3], wb[R];
#pragma unroll
        for (int q = 0; q < R; ++q) { const int row = rowb + q;
#pragma unroll
            for (int p = 0; p < 3; ++p) { ls[q][p] = LSE[((size_t)p * T + row) * 8 + hd]; w[q][p] = *(const u32x4*)(OA + ((size_t)p * T + row) * 512 + 8 * lane); }
            wb[q] = *(const u32x4*)(OB + (size_t)row * 512 + 8 * lane); }
        float va[R][8], vb[R][8], sa[R], sb[R];
#pragma unroll
        for (int q = 0; q < R; ++q) {
            const float mx = fmaxf(ls[q][0], fmaxf(ls[q][1], ls[q][2]));
            float e[3]; e[0] = __builtin_amdgcn_exp2f(ls[q][0] - mx); e[1] = __builtin_amdgcn_exp2f(ls[q][1] - mx); e[2] = __builtin_amdgcn_exp2f(ls[q][2] - mx);
            const float inv = 1.0f / (e[0] + e[1] + e[2]);
#pragma unroll
            for (int k = 0; k < 4; ++k) {
                float lo = 0.f, hi = 0.f;
#pragma unroll
                for (int p = 0; p < 3; ++p) { lo += e[p] * bf_lo(w[q][p][k]); hi += e[p] * bf_hi(w[q][p][k]); }
                va[q][2 * k] = lo * inv; va[q][2 * k + 1] = hi * inv; vb[q][2 * k] = bf_lo(wb[q][k]); vb[q][2 * k + 1] = bf_hi(wb[q][k]);
            }
            sa[q] = 0.f; sb[q] = 0.f;
#pragma unroll
            for (int k = 0; k < 8; ++k) { sa[q] += va[q][k] * va[q][k]; sb[q] += vb[q][k] * vb[q][k]; }
        }
#pragma unroll
        for (int o = 1; o < 64; o <<= 1)
#pragma unroll
            for (int q = 0; q < R; ++q) { sa[q] += __shfl_xor(sa[q], o); sb[q] += __shfl_xor(sb[q], o); }
#pragma unroll
        for (int q = 0; q < R; ++q) { const int row = rowb + q;
            const float ra = 1.0f / sqrtf(sa[q] * (1.0f / 512.0f) + EPS), rb = 1.0f / sqrtf(sb[q] * (1.0f / 512.0f) + EPS);
            u32x4 oa, ob;
            oa.x = pk2(va[q][0] * ra * ga0[0], va[q][1] * ra * ga0[1]); oa.y = pk2(va[q][2] * ra * ga0[2], va[q][3] * ra * ga0[3]); oa.z = pk2(va[q][4] * ra * ga1[0], va[q][5] * ra * ga1[1]); oa.w = pk2(va[q][6] * ra * ga1[2], va[q][7] * ra * ga1[3]);
            ob.x = pk2(vb[q][0] * rb * gb0[0], vb[q][1] * rb * gb0[1]); ob.y = pk2(vb[q][2] * rb * gb0[2], vb[q][3] * rb * gb0[3]); ob.z = pk2(vb[q][4] * rb * gb1[0], vb[q][5] * rb * gb1[1]); ob.w = pk2(vb[q][6] * rb * gb1[2], vb[q][7] * rb * gb1[3]);
            *(u32x4*)(MG + (size_t)row * DM + 8 * lane) = oa; *(u32x4*)(MG + (size_t)row * DM + 512 + 8 * lane) = ob; }
    }
}

__device__ __forceinline__ void cumsum_phase(const float* FL, const float* bforget, float* KBIAS, LAS unsigned char* lds, int tid, int lane, int wave, int b0, int nbat) {
    LAS float* wt = (LAS float*)lds;
    for (int it = b0 * 8 + blockIdx.x; it < (b0 + nbat) * 8; it += gridDim.x) {
        const int b = it >> 3, hd = it & 7; const float bf = bforget[hd];
        float v[4];
#pragma unroll
        for (int i = 0; i < 4; ++i) { const float z = FL[((size_t)b * SEQ + 4 * tid + i) * 8 + hd] + bf; v[i] = fminf(z, 0.f) - log1pf(__expf(-fabsf(z))); }
        v[1] += v[0]; v[2] += v[1]; v[3] += v[2];
        float sc = v[3];
#pragma unroll
        for (int o = 1; o < 64; o <<= 1) { const float t = __shfl_up(sc, o); if (lane >= o) sc += t; }
        __syncthreads();
        if (lane == 63) wt[wave] = sc;
        __syncthreads();
        float off = sc - v[3];
        for (int w = 0; w < wave; ++w) off += wt[w];
        f32x4 o4 = {-(off + v[0]) * LOG2E, -(off + v[1]) * LOG2E, -(off + v[2]) * LOG2E, -(off + v[3]) * LOG2E};
        *(f32x4*)(KBIAS + (size_t)it * SEQ + 4 * tid) = o4;
    }
    __syncthreads();
}

#define XB_TMO      128
#define XB_XCNT(j)  (256  + 64 * (j))
#define XB_XSUB(j)  (1280 + 64 * (j))
#define XB_XGEN(j)  (2304 + 64 * (j))
#define XB_TOP      3328
#define XB_TOPGEN   3392
#define XCD_BAR_WORDS 3456
#define XB_SPIN_CAP (1u << 18)

__device__ __forceinline__ unsigned xb_ld(unsigned* p)              { return __hip_atomic_load(p, __ATOMIC_RELAXED, __HIP_MEMORY_SCOPE_AGENT); }
__device__ __forceinline__ unsigned xb_add(unsigned* p, unsigned v) { return __hip_atomic_fetch_add(p, v, __ATOMIC_RELAXED, __HIP_MEMORY_SCOPE_AGENT); }
__device__ __forceinline__ unsigned xb_xcc_id() { return (unsigned)__builtin_amdgcn_s_getreg((3 << 11) | 20) & 0xFu; }
#define XB_SPIN(cond, bar) do { unsigned _sp = 0; while (cond) { __builtin_amdgcn_s_sleep(1); \
    if ((++_sp & 255u) == 0u) { if (xb_ld(&(bar)[XB_TMO])) break; if (_sp > XB_SPIN_CAP) { atomicAdd(&(bar)[XB_TMO], 1u); break; } } } } while (0)

struct XcdBarrier {
    unsigned* bar; unsigned x;
    volatile LAS unsigned* st;
};

__device__ __forceinline__ XcdBarrier xcd_barrier_post(unsigned* bar, volatile LAS unsigned* st) {
    XcdBarrier b; b.bar = bar; b.x = xb_xcc_id(); b.st = st;
    if (threadIdx.x == 0) (void)xb_add(&bar[XB_XCNT(b.x)], 1u);
    return b;
}
__device__ __forceinline__ void xcd_barrier_complete(unsigned* bar, unsigned x, unsigned& nloc, unsigned& nx) {
    const unsigned G = gridDim.x * gridDim.y * gridDim.z;
    unsigned sum, cnt, mine, sp = 0u;
    for (;;) {
        sum = 0u; cnt = 0u; mine = 0u;
#pragma unroll
        for (unsigned j = 0; j < 16; ++j) { const unsigned c = xb_ld(&bar[XB_XCNT(j)]); sum += c; cnt += (c > 0u) ? 1u : 0u; mine = (j == x) ? c : mine; }
        if (sum == G) break;
        __builtin_amdgcn_s_sleep(1);
        if ((++sp & 255u) == 0u) { if (xb_ld(&bar[XB_TMO])) break; if (sp > XB_SPIN_CAP) { atomicAdd(&bar[XB_TMO], 1u); break; } }
    }
    nloc = mine > 0u ? mine : 1u; nx = cnt > 0u ? cnt : 1u;
}

__device__ __forceinline__ void xcd_barrier(const XcdBarrier& b) {
    asm volatile("s_waitcnt vmcnt(0)" ::: "memory");
    __syncthreads();
    if (threadIdx.x == 0) {
        unsigned* bar = b.bar;
        __builtin_amdgcn_s_waitcnt(0);
        unsigned nloc = b.st[0], nx = b.st[1];
        if (nloc == 0u) { xcd_barrier_complete(bar, b.x, nloc, nx); b.st[0] = nloc; b.st[1] = nx; }
        const unsigned old = xb_add(&bar[XB_XSUB(b.x)], 1u);
        const unsigned gen = old / nloc;
        if (old + 1u == (gen + 1u) * nloc) {
            __builtin_amdgcn_fence(__ATOMIC_RELEASE, "agent");
            asm volatile("s_waitcnt vmcnt(0)" ::: "memory");
            const unsigned og = xb_add(&bar[XB_TOP], 1u);
            const unsigned tg = og / nx;
            if (og + 1u == (tg + 1u) * nx) xb_add(&bar[XB_TOPGEN], 1u);
            else XB_SPIN(xb_ld(&bar[XB_TOPGEN]) == tg, bar);
            __builtin_amdgcn_fence(__ATOMIC_ACQUIRE, "agent");
            xb_add(&bar[XB_XGEN(b.x)], 1u);
            asm volatile("s_waitcnt vmcnt(0)" ::: "memory");
        } else {
            XB_SPIN(xb_ld(&bar[XB_XGEN(b.x)]) == gen, bar);
            __builtin_amdgcn_fence(__ATOMIC_ACQUIRE, "agent");
            asm volatile("s_waitcnt vmcnt(0)" ::: "memory");
        }
    }
    __syncthreads();
}

__global__ void __launch_bounds__(NTHR, 2) mega_fwd(Args a) {
    extern __shared__ __attribute__((aligned(16))) unsigned char lds_raw[];
    LAS unsigned char* lds = (LAS unsigned char*)lds_raw;
    cg::grid_group grid = cg::this_grid();
#define IDS() const int tid = opaque_tid(), lane = tid & 63, wave = __builtin_amdgcn_readfirstlane(tid >> 6); (void)lane; (void)wave
    unsigned char* ws = a.ws;
    bf16_t* H = (bf16_t*)(ws + WS_H); bf16_t* Y = (bf16_t*)(ws + WS_Y); bf16_t* HID = (bf16_t*)(ws + WS_BIG); bf16_t* QKV = (bf16_t*)(ws + WS_BIG);
    bf16_t* OA = (bf16_t*)(ws + WS_OA); bf16_t* OB = (bf16_t*)(ws + WS_OB);
    float* MOD = (float*)(ws + WS_MOD); float* FL = (float*)(ws + WS_FL); float* KBIAS = (float*)(ws + WS_KB); float* LSE = (float*)(ws + WS_LSE);
    const float* x = a.in[0]; float* out = a.out;
    const int G = gridDim.x, cb = blockIdx.x;

    volatile LAS unsigned* bst = (volatile LAS unsigned*)(lds + 151040);
    unsigned* barw = (unsigned*)(ws + WS_BAR);
    { IDS();
    if (tid < 2) bst[tid] = 0u;
    if (blockIdx.x == 0) for (int i = tid; i < XCD_BAR_WORDS; i += NTHR) barw[i] = 0u; }
    { IDS(); p0_phase(a, lds, tid, lane, wave); }
    grid.sync();
    const XcdBarrier bar = xcd_barrier_post(barw, bst);
    for (int st = 1; st <= 13; ++st) {
        const bool r0job = (st == 1 || st == 4 || st == 7 || st == 9 || st == 12);
        const bool r1job = (st == 2 || st == 5 || st == 8 || st == 10 || st == 13);
        const bool odd = (blockIdx.x & 1) != 0;
        const int first = r0job ? (odd ? 0 : 1) : (r1job ? (odd ? 1 : 0) : 0);
        for (int kk = 0; kk < 2; ++kk) {
            const int grp = kk == 0 ? first : 1 - first; const int ph = st - grp;
            if (ph < 1 || ph > 12) continue;
            const int b0 = grp * (NBATCH / 2); const size_t r0 = (size_t)grp * (T / 2); constexpr int NB2 = NBATCH / 2, M2 = T / 2;
            if (ph == 1) { IDS(); rowpass<false, true, false>(x, nullptr, nullptr, H, nullptr, nullptr, a.in[5], MOD, 0, 0.f, 1, 0, nullptr, lane, wave, b0, NB2); }
            else if (ph == 2 || ph == 10) { const bool f2 = ph == 10;
                pg8::Gemm g{H + r0 * DM, (const bf16_t*)(ws + (f2 ? WS_WGU2 : WS_WGU1)), M2, 2 * DFFP, DM}; pg8::StaticOrder S; S.init(M2, 2 * DFFP, G, cb); pg8::EpiSwiglu E{HID + r0 * DFFP, DFFP};
                pg8::gemm_phase<pg8::EpiSwiglu, pg8::StaticOrder, true, true>(lds, g, S, E); }
            else if (ph == 3 || ph == 8 || ph == 11) { const bool o = ph == 8;
                pg8::Gemm g{o ? H + r0 * DM : HID + r0 * DFFP, (const bf16_t*)(ws + (o ? WS_WOUT : (ph == 3 ? WS_WD1 : WS_WD2))), M2, DM, o ? DM : DFFP, o ? 0 : 1}; pg8::StaticOrder S; S.init(M2, DM, G, cb); pg8::EpiPlain E{Y + r0 * DM, DM};
                pg8::gemm_phase<pg8::EpiPlain, pg8::StaticOrder, true, true>(lds, g, S, E); }
            else if (ph == 4) { IDS(); LAS float* wfl = (LAS float*)lds; const float* WF = (const float*)(ws + WS_WF);
                for (int e = tid; e < 8 * DM; e += NTHR) wfl[e] = WF[e];
                __syncthreads();
                rowpass<true, true, true>(x, out, Y, H, FL, a.in[6], a.in[10], MOD, 2, 0.5f, 4, 3, wfl, lane, wave, b0, NB2);
                __syncthreads(); }
            else if (ph == 5) { { IDS(); cumsum_phase(FL, a.in[13], KBIAS, lds, tid, lane, wave, b0, NB2); }
                pg8::Gemm g{H + r0 * DM, (const bf16_t*)(ws + WS_WIN), M2, 3072, DM}; pg8::StaticOrder S; S.init(M2, 3072, G, cb); pg8::EpiQKV E{QKV + r0 * 512, QKV_STRIDE, (const float*)(ws + WS_ROPE) + r0 * 16};
                pg8::gemm_phase<pg8::EpiQKV, pg8::StaticOrder, true, true>(lds, g, S, E); }
            else if (ph == 6) { { IDS(); b_phase2(QKV + 3 * QKV_STRIDE, QKV + 4 * QKV_STRIDE, QKV + 5 * QKV_STRIDE, KBIAS, OB, lds_raw, tid, b0, NB2); }
                { IDS(); att::a_phase(QKV, QKV + QKV_STRIDE, QKV + 2 * QKV_STRIDE, OA, LSE, lds, tid, lane, wave, b0, NB2); } }
            else if (ph == 7) { IDS(); merge_pass(OA, LSE, OB, a.in[14], a.in[15], H, lane, wave, (int)r0, M2); }
            else if (ph == 9) { IDS(); rowpass<true, true, false>(out, out, Y, H, nullptr, a.in[11], a.in[17], MOD, 5, 1.0f, 7, 6, nullptr, lane, wave, b0, NB2); }
            else { IDS(); rowpass<true, false, false>(out, out, Y, nullptr, nullptr, a.in[18], nullptr, MOD, 8, 0.5f, 0, 0, nullptr, lane, wave, b0, NB2); }
        }
        if (st < 13) xcd_barrier(bar);
    }
}

extern "C" void kernel_launch(void* const* d_in, const int* in_sizes, int n_in, void* d_out, int out_size, void* d_ws, size_t ws_size, hipStream_t stream) {
    static int grid = 0;
    if (grid == 0) {
        if (n_in != 22 || in_sizes[0] != T * DM || out_size != T * DM || ws_size < WS_END) { fprintf(stderr, "kernel_launch: unexpected shapes (n_in %d, ws %zu)\n", n_in, ws_size); grid = -1; return; }
        int dev = 0, cus = 0, per_cu = 0;
        (void)hipGetDevice(&dev); (void)hipDeviceGetAttribute(&cus, hipDeviceAttributeMultiprocessorCount, dev);
        if (hipFuncSetAttribute((const void*)mega_fwd, hipFuncAttributeMaxDynamicSharedMemorySize, LDS_BYTES) != hipSuccess) { fprintf(stderr, "kernel_launch: hipFuncSetAttribute failed\n"); grid = -1; return; }
        if (hipOccupancyMaxActiveBlocksPerMultiprocessor(&per_cu, (const void*)mega_fwd, NTHR, LDS_BYTES) != hipSuccess || per_cu < 1) { fprintf(stderr, "kernel_launch: occupancy query says %d\n", per_cu); per_cu = 1; }
        (void)hipGetLastError();
        grid = cus;
    }
    if (grid < 0) return;
    Args a{};
    for (int i = 0; i < 22; ++i) a.in[i] = (const float*)d_in[i];
    a.out = (float*)d_out; a.ws = (unsigned char*)d_ws;
    void* args[] = {&a};
    hipError_t e = hipLaunchCooperativeKernel((const void*)mega_fwd, dim3(grid), dim3(NTHR), args, LDS_BYTES, stream);
    if (e != hipSuccess) fprintf(stderr, "kernel_launch: cooperative launch failed: %s (grid %d)\n", hipGetErrorString(e), grid);
}
```

```cpp
#include <hip/hip_runtime.h>
#include <hip/hip_cooperative_groups.h>
#include <cstdio>
#include <cstdint>
namespace cg = cooperative_groups;
namespace pg8 {
#define PG8_LAS __attribute__((address_space(3)))
typedef unsigned short bf16_t;
typedef short bf16x8 __attribute__((ext_vector_type(8)));
typedef float f32x4 __attribute__((ext_vector_type(4)));
typedef unsigned u32x4 __attribute__((ext_vector_type(4)));
constexpr int BM = 256, BK = 64, HALF = 128, HTB = HALF * BK * 2  , STAGE_BYTES = 8 * HTB, NXCD = 8, WGM = 4;

__host__ __device__ __forceinline__ int lds_byte(int r, int c) { const int st = (r >> 4) * 2 + (c >> 5), rr = r & 15, cc = c & 31, ob = rr * 64 + cc * 2; return st * 1024 + (ob ^ (((ob >> 9) & 1) << 5)); }
__host__ __device__ __forceinline__ void stage_rc(int b, int& R, int& C) { const int st = b / 1024, sb = b % 1024, swz = sb ^ (((sb >> 9) & 1) << 5); R = (st >> 1) * 16 + swz / 64; C = (st & 1) * 32 + (swz % 64) / 2; }
__host__ __device__ __forceinline__ int perm32(int rho) { const int n = rho >> 4, i = rho & 15; return 8 * (i >> 2) + 4 * n + (i & 3); }

struct Unit { int pm, pn; };
struct Gemm { const bf16_t* A; const bf16_t* Bt; int M, N, K; };

struct StaticOrder {
    int nM, nN, nwg, G, c;
    __host__ __device__ void init(int M, int N, int G_, int c_) { nM = M / BM; nN = N / BM; nwg = nM * nN; G = G_; c = c_; }
    __host__ __device__ bool next(int i, Unit& u) const {
        const long L = (long)i * G + c; if (L >= nwg) return false;
        int wgid = (int)L; { const int q = nwg / NXCD, r = nwg % NXCD, xcd = wgid % NXCD, off = wgid / NXCD; wgid = (xcd < r ? xcd * (q + 1) : r * (q + 1) + (xcd - r) * q) + off; }
        const int nig = WGM * nN, gid = wgid / nig, fm = gid * WGM, gsz = (nM - fm) < WGM ? (nM - fm) : WGM;
        u.pm = fm + ((wgid % nig) % gsz); u.pn = (wgid % nig) / gsz; return true;
    }
    __device__ __forceinline__ void a_ready(const Unit&) const {}
    __device__ __forceinline__ void done(const Unit&) const {}
};


__device__ __forceinline__ unsigned cvt_pk_bf16(float lo, float hi) { unsigned r; asm volatile("v_cvt_pk_bf16_f32 %0, %1, %2" : "=v"(r) : "v"(lo), "v"(hi)); return r; }
typedef unsigned u32x4 __attribute__((ext_vector_type(4)));

struct EpiPlain {
    static constexpr bool PERM = true, AFTER_DRAIN = false;
    bf16_t* O; int ldc;
    __device__ __forceinline__ void operator()(const f32x4 (&acc)[2][2][4][2], const Unit& u, int wr, int wc, int fr, int fq) const {
        const int row0 = u.pm * BM + wr * 64 + fr; const int col0 = u.pn * BM + wc * 32 + 8 * fq;
#pragma unroll
        for (int ai = 0; ai < 2; ++ai)
#pragma unroll
            for (int m = 0; m < 4; ++m) { bf16_t* rowp = O + (size_t)(row0 + ai * HALF + m * 16) * ldc + col0;
#pragma unroll
                for (int bj = 0; bj < 2; ++bj) { const f32x4 v0 = acc[ai][bj][m][0], v1 = acc[ai][bj][m][1];
                    u32x4 w; w.x = cvt_pk_bf16(v0[0], v0[1]); w.y = cvt_pk_bf16(v0[2], v0[3]); w.z = cvt_pk_bf16(v1[0], v1[1]); w.w = cvt_pk_bf16(v1[2], v1[3]);
                    *(u32x4*)(rowp + bj * HALF) = w; } }
    }
};
typedef float f32x2 __attribute__((ext_vector_type(2)));
__device__ __forceinline__ f32x2 silu_mul_pk(f32x2 g, f32x2 u) {
    const f32x2 t = g * (-1.4426950408889634f);
    f32x2 e; e.x = __builtin_amdgcn_exp2f(t.x); e.y = __builtin_amdgcn_exp2f(t.y);
    const f32x2 d = e + 1.0f;
    f32x2 r; r.x = __builtin_amdgcn_rcpf(d.x); r.y = __builtin_amdgcn_rcpf(d.y);
    return (g * u) * r;
}
__device__ __forceinline__ unsigned silu_pk_bf16(float g0, float g1, float u0, float u1) { const f32x2 h = silu_mul_pk((f32x2){g0, g1}, (f32x2){u0, u1}); return cvt_pk_bf16(h.x, h.y); }
struct EpiSwiglu {
    static constexpr bool PERM = true, AFTER_DRAIN = false;
    bf16_t* O; int ldc;
    __device__ __forceinline__ void operator()(const f32x4 (&acc)[2][2][4][2], const Unit& u, int wr, int wc, int fr, int fq) const {
        const int row0 = u.pm * BM + wr * 64 + fr; const int col0 = u.pn * HALF + wc * 32 + 8 * fq;
#pragma unroll
        for (int ai = 0; ai < 2; ++ai)
#pragma unroll
            for (int m = 0; m < 4; ++m) { bf16_t* rowp = O + (size_t)(row0 + ai * HALF + m * 16) * ldc + col0;
                const f32x4 g0 = acc[ai][0][m][0], g1 = acc[ai][0][m][1], u0 = acc[ai][1][m][0], u1 = acc[ai][1][m][1];
                u32x4 w;
                w.x = silu_pk_bf16(g0[0], g0[1], u0[0], u0[1]); w.y = silu_pk_bf16(g0[2], g0[3], u0[2], u0[3]);
                w.z = silu_pk_bf16(g1[0], g1[1], u1[0], u1[1]); w.w = silu_pk_bf16(g1[2], g1[3], u1[2], u1[3]);
                *(u32x4*)rowp = w; }
    }
};
struct EpiQKV {
    static constexpr bool PERM = true, AFTER_DRAIN = false;
    bf16_t* O; size_t stride; const float* rope;
    __device__ __forceinline__ void operator()(const f32x4 (&acc)[2][2][4][2], const Unit& u, int wr, int wc, int fr, int fq) const {
        const int t = u.pn >> 1; const int colt = (u.pn & 1) * BM;
        bf16_t* base = O + (size_t)t * stride;
        const int row0 = u.pm * BM + wr * 64 + fr; const int col0 = colt + wc * 32 + 8 * fq;
        const bool rot = (t < 2) && ((wc & 1) == 0);
        const float sgn = (fq == 0) ? -1.f : 1.f;
        const float qsc = (t == 3) ? 0.18033688011112042f : 1.0f;
#pragma unroll
        for (int ai = 0; ai < 2; ++ai)
#pragma unroll
            for (int m = 0; m < 4; ++m) { const int row = row0 + ai * HALF + m * 16; bf16_t* rowp = base + (size_t)row * 512 + col0;
                f32x4 c0 = {1.f, 1.f, 1.f, 1.f}, c1 = c0, s0 = {0.f, 0.f, 0.f, 0.f}, s1 = s0;
                if (rot && fq < 2) { const f32x4* rp = (const f32x4*)(rope + (size_t)row * 16); c0 = rp[0]; c1 = rp[1]; s0 = rp[2] * sgn; s1 = rp[3] * sgn; }
#pragma unroll
                for (int bj = 0; bj < 2; ++bj) { f32x4 v0 = acc[ai][bj][m][0], v1 = acc[ai][bj][m][1];
                    if (rot) {
                        f32x4 p0, p1;
#pragma unroll
                        for (int j = 0; j < 4; ++j) { p0[j] = __shfl_xor(v0[j], 16); p1[j] = __shfl_xor(v1[j], 16); }
                        v0 = v0 * c0 + p0 * s0; v1 = v1 * c1 + p1 * s1;
                    }
                    v0 = v0 * qsc; v1 = v1 * qsc;
                    u32x4 w; w.x = cvt_pk_bf16(v0[0], v0[1]); w.y = cvt_pk_bf16(v0[2], v0[3]); w.z = cvt_pk_bf16(v1[0], v1[1]); w.w = cvt_pk_bf16(v1[2], v1[3]);
                    *(u32x4*)(rowp + bj * HALF) = w; } }
    }
};

template <class Epi, class Sched, bool ALIGN_EPI = false, bool SP2 = false>
__device__ __forceinline__ void gemm_phase(PG8_LAS unsigned char* lds, const Gemm g, const Sched& S, const Epi& E) {
    int tid_o = threadIdx.x; asm volatile("" : "+v"(tid_o));
    const int tid = tid_o, wid = __builtin_amdgcn_readfirstlane(tid >> 6), lane = tid & 63, wr = wid >> 2, wc = wid & 3, fr = lane & 15, fq = lane >> 4;
    const int K = g.K, nt = K / BK;
    unsigned voffA[2], voffB[2];
#pragma unroll
    for (int i = 0; i < 2; ++i) { int R, C; stage_rc(tid * 16 + i * 8192, R, C); const int Rb = Epi::PERM ? ((R & ~31) + perm32(R & 31)) : R;
        voffA[i] = (unsigned)(R * K + C) * 2u; voffB[i] = (unsigned)(Rb * K + C) * 2u; }
    const size_t kstep = (size_t)(BK * 2);
    const size_t hstep = (size_t)HALF * K * 2;
    const size_t tstep = 2 * hstep;
    const unsigned ldsw = (unsigned)wid * 1024u;
    const int aoff = lds_byte(wr * 64 + fr, fq * 8), boff = lds_byte(wc * 32 + fr, fq * 8);
#define PG8_SA(b, h) (((b) * 2 + (h)) * HTB)
#define PG8_SB(b, h) ((4 + (b) * 2 + (h)) * HTB)
#define PG8_STAGE(bufoff, gbase, voff) do { _Pragma("unroll") for (int _i = 0; _i < 2; ++_i) \
        __builtin_amdgcn_global_load_lds((const unsigned*)((const char*)(gbase) + (voff)[_i]), (PG8_LAS unsigned*)(lds + (bufoff) + ldsw + _i * 8192), 16, 0, 0); } while (0)
#define PG8_LDA(dst, b, h) do { _Pragma("unroll") for (int m = 0; m < 4; ++m) _Pragma("unroll") for (int k = 0; k < 2; ++k) dst[m][k] = *(const PG8_LAS bf16x8*)(lds + PG8_SA(b, h) + aoff + m * 2048 + k * 1024); } while (0)
#define PG8_LDB(dst, b, h) do { _Pragma("unroll") for (int n = 0; n < 2; ++n) _Pragma("unroll") for (int k = 0; k < 2; ++k) dst[n][k] = *(const PG8_LAS bf16x8*)(lds + PG8_SB(b, h) + boff + n * 2048 + k * 1024); } while (0)
#define PG8_MMA(ai, bj, At, Bt) do { __builtin_amdgcn_s_setprio(1); _Pragma("unroll") for (int m = 0; m < 4; ++m) _Pragma("unroll") for (int n = 0; n < 2; ++n) _Pragma("unroll") for (int k = 0; k < 2; ++k) \
        acc[ai][bj][m][n] = __builtin_amdgcn_mfma_f32_16x16x32_bf16(Bt[n][k], At[m][k], acc[ai][bj][m][n], 0, 0, 0); __builtin_amdgcn_s_setprio(0); } while (0)
#define PG8_WAIT_V(n) asm volatile("s_waitcnt vmcnt(" #n ")" ::: "memory")
#define PG8_WAIT_L(n) asm volatile("s_waitcnt lgkmcnt(" #n ")" ::: "memory")
#define PG8_BAR __builtin_amdgcn_s_barrier()
#define PG8_SCHED __builtin_amdgcn_sched_barrier(0)
    Unit cur, nxt; int ui = 0;
    if (!S.next(0, cur)) return;
    f32x4 acc[2][2][4][2];
#pragma unroll
    for (int a = 0; a < 2; ++a)
#pragma unroll
        for (int b = 0; b < 2; ++b)
#pragma unroll
            for (int m = 0; m < 4; ++m)
#pragma unroll
                for (int n = 0; n < 2; ++n) acc[a][b][m][n] = (f32x4){0.f, 0.f, 0.f, 0.f};
    bf16x8 At[4][2], B0[2][2], B1[2][2];
    const char* cA = (const char*)g.A + (size_t)cur.pm * tstep; const char* cB = (const char*)g.Bt + (size_t)cur.pn * tstep;
    S.a_ready(cur);
    if constexpr (SP2) {
        PG8_STAGE(PG8_SB(0, 0), cB, voffB); PG8_STAGE(PG8_SB(0, 1), cB + hstep, voffB); PG8_STAGE(PG8_SA(0, 0), cA, voffA); PG8_STAGE(PG8_SA(0, 1), cA + hstep, voffA);
        if (wr == 1) PG8_BAR;
        PG8_WAIT_V(2); PG8_BAR;
        PG8_STAGE(PG8_SB(1, 0), cB + kstep, voffB); PG8_STAGE(PG8_SA(1, 0), cA + kstep, voffA); PG8_STAGE(PG8_SB(1, 1), cB + hstep + kstep, voffB);
        PG8_WAIT_V(6); PG8_BAR;
    } else {
        PG8_STAGE(PG8_SB(0, 0), cB, voffB); PG8_STAGE(PG8_SA(0, 0), cA, voffA); PG8_STAGE(PG8_SB(0, 1), cB + hstep, voffB); PG8_STAGE(PG8_SA(0, 1), cA + hstep, voffA);
        if (wr == 1) PG8_BAR;
        PG8_WAIT_V(4); PG8_BAR;
        PG8_STAGE(PG8_SB(1, 0), cB + kstep, voffB); PG8_STAGE(PG8_SA(1, 0), cA + kstep, voffA); PG8_STAGE(PG8_SB(1, 1), cB + hstep + kstep, voffB);
        PG8_WAIT_V(6); PG8_BAR;
    }
    for (;;) {
        const bool has_next = S.next(ui + 1, nxt);
        const char* nA = has_next ? (const char*)g.A + (size_t)nxt.pm * tstep : cA; const char* nB = has_next ? (const char*)g.Bt + (size_t)nxt.pn * tstep : cB;
        for (int t = 0; t < nt; t += 2) {
            const bool last = (t == nt - 2);
            const char* a1 = cA + (size_t)(t + 1) * kstep;
            const char* a2 = last ? nA : cA + (size_t)(t + 2) * kstep; const char* b2 = last ? nB : cB + (size_t)(t + 2) * kstep;
            const char* a3 = a2 + kstep; const char* b3 = b2 + kstep;
            if (last && has_next) S.a_ready(nxt);
            if constexpr (SP2) {
            PG8_LDB(B0, 0, 0); PG8_LDB(B1, 0, 1); PG8_SCHED; PG8_LDA(At, 0, 0); PG8_STAGE(PG8_SA(1, 1), a1 + hstep, voffA);
            PG8_WAIT_V(8); PG8_WAIT_L(0); PG8_BAR; PG8_MMA(0, 0, At, B0); PG8_MMA(0, 1, At, B1); PG8_BAR; PG8_SCHED;
            PG8_LDA(At, 0, 1); PG8_STAGE(PG8_SB(0, 0), b2, voffB); PG8_STAGE(PG8_SB(0, 1), b2 + hstep, voffB); PG8_STAGE(PG8_SA(0, 0), a2, voffA);
            PG8_WAIT_V(8); PG8_WAIT_L(0); PG8_BAR; PG8_MMA(1, 0, At, B0); PG8_MMA(1, 1, At, B1); PG8_BAR; PG8_SCHED;
            PG8_LDB(B0, 1, 0); PG8_LDB(B1, 1, 1); PG8_SCHED; PG8_LDA(At, 1, 0); PG8_STAGE(PG8_SA(0, 1), a2 + hstep, voffA);
            PG8_WAIT_V(8); PG8_WAIT_L(0); PG8_BAR; PG8_MMA(0, 0, At, B0); PG8_MMA(0, 1, At, B1); PG8_BAR; PG8_SCHED;
            PG8_LDA(At, 1, 1); PG8_STAGE(PG8_SB(1, 0), b3, voffB); PG8_STAGE(PG8_SB(1, 1), b3 + hstep, voffB); PG8_STAGE(PG8_SA(1, 0), a3, voffA);
            PG8_WAIT_V(8); PG8_WAIT_L(0); PG8_BAR; PG8_MMA(1, 0, At, B0); PG8_MMA(1, 1, At, B1); PG8_BAR; PG8_SCHED;
            } else {
            PG8_LDB(B0, 0, 0); PG8_SCHED; PG8_LDA(At, 0, 0); PG8_STAGE(PG8_SA(1, 1), a1 + hstep, voffA);
            PG8_WAIT_L(8); PG8_BAR; PG8_WAIT_L(0); PG8_MMA(0, 0, At, B0); PG8_BAR; PG8_SCHED;
            PG8_LDB(B1, 0, 1); PG8_STAGE(PG8_SB(0, 0), b2, voffB);
            PG8_BAR; PG8_WAIT_L(0); PG8_MMA(0, 1, At, B1); PG8_BAR;
            PG8_LDA(At, 0, 1); PG8_STAGE(PG8_SA(0, 0), a2, voffA);
            PG8_BAR; PG8_WAIT_L(0); PG8_MMA(1, 0, At, B0); PG8_BAR; PG8_SCHED;
            PG8_STAGE(PG8_SB(0, 1), b2 + hstep, voffB);
            PG8_WAIT_V(6); PG8_BAR; PG8_MMA(1, 1, At, B1); PG8_BAR;
            PG8_LDB(B0, 1, 0); PG8_SCHED; PG8_LDA(At, 1, 0); PG8_STAGE(PG8_SA(0, 1), a2 + hstep, voffA);
            PG8_WAIT_L(8); PG8_BAR; PG8_WAIT_L(0); PG8_MMA(0, 0, At, B0); PG8_BAR; PG8_SCHED;
            PG8_LDB(B1, 1, 1); PG8_STAGE(PG8_SB(1, 0), b3, voffB);
            PG8_BAR; PG8_WAIT_L(0); PG8_MMA(0, 1, At, B1); PG8_BAR;
            PG8_LDA(At, 1, 1); PG8_STAGE(PG8_SA(1, 0), a3, voffA);
            PG8_BAR; PG8_WAIT_L(0); PG8_MMA(1, 0, At, B0); PG8_BAR; PG8_SCHED;
            PG8_STAGE(PG8_SB(1, 1), b3 + hstep, voffB);
            PG8_WAIT_V(6); PG8_BAR; PG8_MMA(1, 1, At, B1); PG8_BAR;
            }
        }
        if constexpr (ALIGN_EPI) { if (wr == 0) PG8_BAR; }
        if constexpr (!Epi::AFTER_DRAIN) { E(acc, cur, wr, wc, fr, fq); S.done(cur); }
        if (!has_next) break;
#pragma unroll
        for (int a = 0; a < 2; ++a)
#pragma unroll
            for (int b = 0; b < 2; ++b)
#pragma unroll
                for (int m = 0; m < 4; ++m)
#pragma unroll
                    for (int n = 0; n < 2; ++n) acc[a][b][m][n] = (f32x4){0.f, 0.f, 0.f, 0.f};
        cur = nxt; cA = nA; cB = nB; ++ui;
        if constexpr (ALIGN_EPI) { if (wr == 1) PG8_BAR; }
    }
    PG8_WAIT_V(0);
    if constexpr (!ALIGN_EPI) { if (wr == 0) PG8_BAR; }
    PG8_BAR;
    if constexpr (Epi::AFTER_DRAIN) { E.fused(acc, cur, wr, wc, fr, fq, lds, wid, lane); S.done(cur); }
#undef PG8_SA
#undef PG8_SB
#undef PG8_STAGE
#undef PG8_LDA
#undef PG8_LDB
#undef PG8_MMA
#undef PG8_WAIT_V
#undef PG8_WAIT_L
#undef PG8_BAR
#undef PG8_SCHED
}
}
#include <hip/hip_bf16.h>
#include <cmath>
namespace attn_body {
using bf16=__hip_bfloat16;
using bf16x8=__attribute__((ext_vector_type(8)))short;
using s16x4=__attribute__((ext_vector_type(4)))short;
using f32x16=__attribute__((ext_vector_type(16)))float;
using u32x4=__attribute__((ext_vector_type(4)))unsigned;
using f32x4_t=__attribute__((ext_vector_type(4)))float;
constexpr int BATCH=32,NHEAD=8,SEQ=2048,D=64,DM=512;
constexpr int NW=8,QBLK=32,QB=QBLK*NW,KVBLK=64,NQB=SEQ/QB;
constexpr int ATTN_PITCH=DM, ATTN_UNIT_ROWS=QB;
__device__ __forceinline__ int crow(int r,int hi){return (r&3)+8*(r>>2)+4*hi;}
#define SBAR() __builtin_amdgcn_sched_barrier(0)
__device__ __forceinline__ void cmask(f32x16&p0,f32x16&p1,int jb,int qrel,int hi){
  const float NEG=-INFINITY; int lim=qrel-64*jb-4*hi; asm volatile("":"+v"(lim));
  #pragma unroll
  for(int r=0;r<16;++r){const int c=(r&3)+8*(r>>2); if(c>lim)p0[r]=NEG; if(c+32>lim)p1[r]=NEG;}
}

constexpr int NSLOT=3, SLOTB=8192;
constexpr int LDS_K=0, LDS_V=NSLOT*SLOTB, LDS_WS=2*NSLOT*SLOTB, LDS_OST=LDS_WS+NW*64*4, LDS_KB=LDS_OST+NW*4096, LDS_BYTES=LDS_KB+SEQ*4;
constexpr float C2=0.125f*1.4426950408889634f;
__device__ __forceinline__ void glds16(const void*gsrc,unsigned lds_dst){unsigned keep;
  asm volatile("s_mov_b32 %0, m0\n\ts_mov_b32 m0, %2\n\ts_nop 0\n\tglobal_load_lds_dwordx4 %1, off\n\ts_mov_b32 m0, %0":"=&s"(keep):"v"(gsrc),"s"(lds_dst):"memory");}
__device__ __forceinline__ float max3f(float a,float b,float c){float r;asm("v_max3_f32 %0, %1, %2, %3":"=v"(r):"v"(a),"v"(b),"v"(c));return r;}
__device__ __forceinline__ float max2f(float a,float b){float r;asm("v_max_f32_e32 %0, %1, %2":"=v"(r):"v"(a),"v"(b));return r;}
__device__ __forceinline__ float fadd_s(float a,float b){float r;asm("v_add_f32_e32 %0, %1, %2":"=v"(r):"v"(a),"v"(b));return r;}
__device__ __forceinline__ float fsub_s(float a,float b){float r;asm("v_sub_f32_e32 %0, %1, %2":"=v"(r):"v"(a),"v"(b));return r;}
typedef float f32x2_t __attribute__((ext_vector_type(2))); typedef __bf16 bf16x2_t __attribute__((ext_vector_type(2)));
__device__ __forceinline__ unsigned cvtpk_s(float lo,float hi){f32x2_t v={lo,hi};bf16x2_t b=__builtin_convertvector(v,bf16x2_t);return __builtin_bit_cast(unsigned,b);}
#define WAIT_BAR(N) asm volatile("s_waitcnt vmcnt(" #N ") lgkmcnt(0)\n\ts_barrier":::"memory")

__device__ __forceinline__ void qkt(f32x16&p0,f32x16&p1,const char*Kslot,const bf16x8*qr,const f32x16&c0,const f32x16&c1,int r32,int hi){
  const char*kb=Kslot+hi*1024+r32*16;
  #pragma unroll
  for(int d0=0;d0<4;++d0){
    const bf16x8 b0=*reinterpret_cast<const bf16x8*>(kb+d0*2048);
    const bf16x8 b1=*reinterpret_cast<const bf16x8*>(kb+d0*2048+512);
    if(d0==0){p0=__builtin_amdgcn_mfma_f32_32x32x16_bf16(b0,qr[0],c0,0,0,0);p1=__builtin_amdgcn_mfma_f32_32x32x16_bf16(b1,qr[0],c1,0,0,0);}
    else{p0=__builtin_amdgcn_mfma_f32_32x32x16_bf16(b0,qr[d0],p0,0,0,0);p1=__builtin_amdgcn_mfma_f32_32x32x16_bf16(b1,qr[d0],p1,0,0,0);}}
}
typedef __attribute__((address_space(3))) const char* lds_cptr;
typedef short v4i16_t __attribute__((ext_vector_type(4)));
__device__ __forceinline__ void kload8(bf16x8*kf,lds_cptr kp){
  kf[0]=*(const __attribute__((address_space(3))) bf16x8*)(kp);      kf[1]=*(const __attribute__((address_space(3))) bf16x8*)(kp+512);
  kf[2]=*(const __attribute__((address_space(3))) bf16x8*)(kp+2048); kf[3]=*(const __attribute__((address_space(3))) bf16x8*)(kp+2560);
  kf[4]=*(const __attribute__((address_space(3))) bf16x8*)(kp+4096); kf[5]=*(const __attribute__((address_space(3))) bf16x8*)(kp+4608);
  kf[6]=*(const __attribute__((address_space(3))) bf16x8*)(kp+6144); kf[7]=*(const __attribute__((address_space(3))) bf16x8*)(kp+6656);
}
__device__ __forceinline__ void kload2(bf16x8*kf,lds_cptr kp,int j){ kf[2*j]=*(const __attribute__((address_space(3))) bf16x8*)(kp+j*2048); kf[2*j+1]=*(const __attribute__((address_space(3))) bf16x8*)(kp+j*2048+512); }
__device__ __forceinline__ s16x4 vtr(lds_cptr p){ return __builtin_bit_cast(s16x4,__builtin_amdgcn_ds_read_tr16_b64_v4i16((__attribute__((address_space(3))) v4i16_t*)p)); }
__device__ __forceinline__ float rowmax(const f32x16&p0,const f32x16&p1){
  float a=max3f(p0[0],p0[1],p1[0]),b=max3f(p0[2],p0[3],p1[1]);a=max3f(a,p1[2],p1[3]);
  #pragma unroll
  for(int r=4;r<16;r+=4){a=max3f(a,p0[r],p0[r+1]);b=max3f(b,p0[r+2],p0[r+3]);a=max3f(a,p1[r],p1[r+1]);b=max3f(b,p1[r+2],p1[r+3]);}
  const float m=max2f(a,b);
  auto rr=__builtin_amdgcn_permlane32_swap(__float_as_uint(m),__float_as_uint(m),false,false);
  return max2f(__uint_as_float(rr[0]),__uint_as_float(rr[1]));
}
__device__ __forceinline__ void pv(f32x16*o,int vb,bf16x8 pa0,bf16x8 pa1,bf16x8 pa2,bf16x8 pa3){
  #pragma unroll
  for(int d0=0;d0<2;++d0){s16x4 lo[4],hi[4];
    #pragma unroll
    for(int ks=0;ks<4;++ks){
      asm volatile("ds_read_b64_tr_b16 %0,%1 offset:%c2":"=&v"(lo[ks]):"v"(vb),"i"(d0*4096+ks*1024):"memory");
      asm volatile("ds_read_b64_tr_b16 %0,%1 offset:%c2":"=&v"(hi[ks]):"v"(vb),"i"(d0*4096+ks*1024+512):"memory");}
    asm volatile("s_waitcnt lgkmcnt(0)":::"memory");SBAR();
    #define PK(k) (bf16x8){lo[k][0],lo[k][1],lo[k][2],lo[k][3],hi[k][0],hi[k][1],hi[k][2],hi[k][3]}
    o[d0]=__builtin_amdgcn_mfma_f32_32x32x16_bf16(pa0,PK(0),o[d0],0,0,0);
    o[d0]=__builtin_amdgcn_mfma_f32_32x32x16_bf16(pa1,PK(1),o[d0],0,0,0);
    o[d0]=__builtin_amdgcn_mfma_f32_32x32x16_bf16(pa2,PK(2),o[d0],0,0,0);
    o[d0]=__builtin_amdgcn_mfma_f32_32x32x16_bf16(pa3,PK(3),o[d0],0,0,0);
    #undef PK
  }
}

#ifndef ATTN_STORE16
#define ATTN_STORE16(p,v) (*(u32x4*)(p)=(v))
#endif
template<int THRL> __device__ __forceinline__ void attn_unit(int b,int h,int qb,const bf16*Q,const bf16*__restrict__ K,const bf16*__restrict__ V,bf16*O,char*shm){
  int tid_o=threadIdx.x; asm volatile("":"+v"(tid_o));
  const int tid=tid_o,lane=tid&63,r32=lane&31,hi=lane>>5; const int wid=__builtin_amdgcn_readfirstlane(tid>>6);
  const long rowbase=(long)b*SEQ; const int q0=qb*QB;
  const bf16*Qw=Q+(rowbase+q0+wid*QBLK)*DM+h*D;
  const bf16*Kh=K+rowbase*DM+h*D,*Vh=V+rowbase*DM+h*D;
  const unsigned lds0=(unsigned)(uintptr_t)shm;
  float*wsf=(float*)(shm+LDS_WS)+wid*64;
  const bf16*ksrc=Kh+(long)(lane+q0+QB-KVBLK)*DM+wid*8;
  const bf16*vsrc=Vh+(long)(16*(wid&3)+(lane>>2)+q0+QB-KVBLK)*DM+(wid>>2)*32+(lane&3)*8;
  const unsigned kdst=lds0+LDS_K+wid*1024, vdst=lds0+LDS_V+wid*1024;
  #define DMA_K(t,slot) glds16(ksrc-(long)(t)*KVBLK*DM,(unsigned)__builtin_amdgcn_readfirstlane(kdst+(slot)))
  #define DMA_V(t,slot) glds16(vsrc-(long)(t)*KVBLK*DM,(unsigned)__builtin_amdgcn_readfirstlane(vdst+(slot)))
  const int vb0=(int)(lds0+LDS_V)+((lane>>4)&1)*32+(lane&3)*8+(4*hi+((lane&15)>>2))*64;
  const char*Kbase=shm+LDS_K; bf16x8 kf[8];
  const lds_cptr shm3=(lds_cptr)shm; const lds_cptr kp0=shm3+LDS_K+hi*1024+r32*16; const lds_cptr vp0=shm3+LDS_V+((lane>>4)&1)*32+(lane&3)*8+(4*hi+((lane&15)>>2))*64;
  const int NT=(q0+QB)/KVBLK;
  DMA_K(0,0);DMA_V(0,0);DMA_K(1,SLOTB);
  bf16x8 qr[4];
  #pragma unroll
  for(int d0=0;d0<4;++d0)qr[d0]=*reinterpret_cast<const bf16x8*>(&Qw[(long)r32*DM+d0*16+hi*8]);
  float mhat=0.f,l_reg=0.f;f32x16 o[2];o[0]=f32x16{};o[1]=f32x16{};  typedef __attribute__((address_space(3))) const f32x4_t* lds_f4ptr; const lds_f4ptr kbl4=(lds_f4ptr)(shm3+LDS_KB)+hi+(q0+QB-KVBLK)/4;
  #define NB0(t,N0) do{ _Pragma("unroll") for(int g_=0;g_<4;++g_){ const f32x4_t v0_=kbl4[2*g_-16*(t)]; \
      _Pragma("unroll") for(int j_=0;j_<4;++j_){ N0[4*g_+j_]=v0_[j_]-mhat; } } }while(0)
  #define NB1(t,N1) do{ _Pragma("unroll") for(int g_=0;g_<4;++g_){ const f32x4_t v1_=kbl4[8+2*g_-16*(t)]; \
      _Pragma("unroll") for(int j_=0;j_<4;++j_){ N1[4*g_+j_]=v1_[j_]-mhat; } } }while(0)
  const int qrel=wid*QBLK+r32;
  #define CMASK(P0,P1,t) do{int jb_=3-(t); if(jb_>=0)cmask(P0,P1,jb_,qrel,hi);}while(0)
  bool resc=false;
  #define START(P0,P1) do{ const float rm=rowmax(P0,P1); resc=false; \
    { const float dl=(rm==-INFINITY)?0.f:rm; mhat=fadd_s(mhat,dl); \
      _Pragma("unroll") for(int r=0;r<16;++r){P0[r]=fsub_s(P0[r],dl);P1[r]=fsub_s(P1[r],dl);} \
      } \
    _Pragma("unroll") for(int r=0;r<16;++r)P0[r]=__builtin_amdgcn_exp2f(P0[r]); }while(0)
  #define RESC() do{ if(resc){ asm volatile("s_waitcnt lgkmcnt(0)":::"memory"); \
      _Pragma("unroll") for(int d_=0;d_<2;++d_) _Pragma("unroll") for(int r=0;r<16;++r)o[d_][r]*=wsf[crow(r,hi)]; } }while(0)
  f32x16 pA0,pA1,pB0,pB1;
  int sl_prev=0,sl_cur=0,sl_next=SLOTB;
  #define ROT() do{sl_prev=sl_cur;sl_cur=sl_next;sl_next=(sl_next==(NSLOT-1)*SLOTB)?0:sl_next+SLOTB;}while(0)
  DMA_K(2,2*SLOTB);
  WAIT_BAR(3);
  { f32x16 nb0_,nb1_; NB0(0,nb0_); NB1(0,nb1_); qkt(pA0,pA1,Kbase,qr,nb0_,nb1_,r32,hi); }asm volatile("s_nop 15\n\ts_nop 7":"+v"(pA0),"+v"(pA1));CMASK(pA0,pA1,0);
  START(pA0,pA1);
  f32x16 nbc; NB0(1,nbc);
  _Pragma("unroll") for(int r=0;r<16;++r)pA1[r]=__builtin_amdgcn_exp2f(pA1[r]);
  WAIT_BAR(0);
  DMA_K(3,0);DMA_V(1,SLOTB);
  ROT();
  kload8(kf,kp0+sl_cur);
  WAIT_BAR(2);
  s16x4 vlo[8],vhi[8]; u32x4 pw0,pw1,pw2,pw3;
  #define PKW(P,B) cvtpk_s(P[B],P[B+1])
  #define PAF(k) __builtin_bit_cast(bf16x8,pw##k)
  #define VFR(i) (bf16x8){vlo[i][0],vlo[i][1],vlo[i][2],vlo[i][3],vhi[i][0],vhi[i][1],vhi[i][2],vhi[i][3]}
  #define PIN(x) asm volatile("":"+v"(x))
  #define MX3(a,b,c) __builtin_fmaxf(__builtin_fmaxf((a),(b)),(c))
  #define GAPA(MF,A0,A1,A2,A3,W0,W1,PW) do{ MF; sacc+=A0; sacc+=A1; sacc+=A2; sacc+=A3; PIN(sacc); W0; W1; PIN(PW); SBAR(); }while(0)
  #define EX(v) __builtin_amdgcn_exp2f(v)
  #define GAPB(MF,X,B) do{ MF; X[B]=EX(X[B]); X[B+1]=EX(X[B+1]); X[B+2]=EX(X[B+2]); X[B+3]=EX(X[B+3]); PIN(X); SBAR(); }while(0)
  #define VRD(i) do{ vlo[i]=vtr(vp_+(((i)>>2)*4096+((i)&3)*1024)); vhi[i]=vtr(vp_+(((i)>>2)*4096+((i)&3)*1024+512)); }while(0)
  #define KRD(G,j) do{ if(G){ kload2(kf,kp0+sl_next,j); SBAR(); } }while(0)
  #define STEP(C0,C1,P0,P1,t,GK,GV,GL) do{ SBAR(); f32x16 nb1_; \
    const lds_cptr vp_=vp0+sl_prev; \
    VRD(0); SBAR(); float sacc=(P0[0]+P0[1]); \
    GAPA(C0=__builtin_amdgcn_mfma_f32_32x32x16_bf16(kf[0],qr[0],nbc,0,0,0), P0[2],P0[3],P0[4],P0[5],     pw0[0]=PKW(P0,0), pw0[1]=PKW(P0,2), pw0); \
    NB1(t,nb1_); VRD(4); SBAR(); GAPA(C1=__builtin_amdgcn_mfma_f32_32x32x16_bf16(kf[1],qr[0],nb1_,0,0,0), P0[6],P0[7],P0[8],P0[9],     pw0[2]=PKW(P0,4), pw0[3]=PKW(P0,6), pw0); \
    VRD(1); SBAR(); GAPA(C0=__builtin_amdgcn_mfma_f32_32x32x16_bf16(kf[2],qr[1],C0,0,0,0),   P0[10],P0[11],P0[12],P0[13], pw1[0]=PKW(P0,8), pw1[1]=PKW(P0,10), pw1); \
    VRD(5); SBAR(); GAPA(C1=__builtin_amdgcn_mfma_f32_32x32x16_bf16(kf[3],qr[1],C1,0,0,0),   P0[14],P0[15],P1[0],P1[1],   pw1[2]=PKW(P0,12),pw1[3]=PKW(P0,14), pw1); \
    VRD(2); SBAR(); GAPA(C0=__builtin_amdgcn_mfma_f32_32x32x16_bf16(kf[4],qr[2],C0,0,0,0),   P1[2],P1[3],P1[4],P1[5],     pw2[0]=PKW(P1,0), pw2[1]=PKW(P1,2), pw2); \
    VRD(6); SBAR(); GAPA(C1=__builtin_amdgcn_mfma_f32_32x32x16_bf16(kf[5],qr[2],C1,0,0,0),   P1[6],P1[7],P1[8],P1[9],     pw2[2]=PKW(P1,4), pw2[3]=PKW(P1,6), pw2); \
    VRD(3); SBAR(); GAPA(C0=__builtin_amdgcn_mfma_f32_32x32x16_bf16(kf[6],qr[3],C0,0,0,0),   P1[10],P1[11],P1[12],P1[13], pw3[0]=PKW(P1,8), pw3[1]=PKW(P1,10), pw3); \
    VRD(7); SBAR(); GAPA(C1=__builtin_amdgcn_mfma_f32_32x32x16_bf16(kf[7],qr[3],C1,0,0,0),   P1[14],P1[15],0.f,0.f,       pw3[2]=PKW(P1,12),pw3[3]=PKW(P1,14), pw3); \
    l_reg+=sacc; \
    if(GK){DMA_K((t)+3,sl_cur);} if(GV){DMA_V((t)+1,sl_next);} \
    CMASK(C0,C1,t); \
    { float a=MX3(C0[0],C0[1],C1[0]),b=MX3(C0[2],C0[3],C1[1]); a=MX3(a,C1[2],C1[3]); \
      _Pragma("unroll") for(int r=4;r<16;r+=4){a=MX3(a,C0[r],C0[r+1]);b=MX3(b,C0[r+2],C0[r+3]);a=MX3(a,C1[r],C1[r+1]);b=MX3(b,C1[r+2],C1[r+3]);} \
      float rm=__builtin_fmaxf(a,b); { auto rr=__builtin_amdgcn_permlane32_swap(__float_as_uint(rm),__float_as_uint(rm),false,false); rm=__builtin_fmaxf(__uint_as_float(rr[0]),__uint_as_float(rr[1])); } \
      resc=false; \
      if(__builtin_expect(__any(rm>(float)THRL),0)){ const float dl=__builtin_fmaxf(rm,0.f); mhat+=dl; \
        _Pragma("unroll") for(int r=0;r<16;++r){C0[r]-=dl;C1[r]-=dl;} \
        const float f=__builtin_amdgcn_exp2f(-dl); l_reg*=f; if(hi==0)wsf[r32]=f; resc=true; } } \
    SBAR(); \
    GAPB(o[0]=__builtin_amdgcn_mfma_f32_32x32x16_bf16(PAF(0),VFR(0),o[0],0,0,0), C0,0); \
    GAPB(o[1]=__builtin_amdgcn_mfma_f32_32x32x16_bf16(PAF(0),VFR(4),o[1],0,0,0), C0,4); \
    KRD(GL,0); GAPB(o[0]=__builtin_amdgcn_mfma_f32_32x32x16_bf16(PAF(1),VFR(1),o[0],0,0,0), C0,8); \
    KRD(GL,1); GAPB(o[1]=__builtin_amdgcn_mfma_f32_32x32x16_bf16(PAF(1),VFR(5),o[1],0,0,0), C0,12); \
    KRD(GL,2); GAPB(o[0]=__builtin_amdgcn_mfma_f32_32x32x16_bf16(PAF(2),VFR(2),o[0],0,0,0), C1,0); \
    KRD(GL,3); GAPB(o[1]=__builtin_amdgcn_mfma_f32_32x32x16_bf16(PAF(2),VFR(6),o[1],0,0,0), C1,4); \
    GAPB(o[0]=__builtin_amdgcn_mfma_f32_32x32x16_bf16(PAF(3),VFR(3),o[0],0,0,0), C1,8); \
    GAPB(o[1]=__builtin_amdgcn_mfma_f32_32x32x16_bf16(PAF(3),VFR(7),o[1],0,0,0), C1,12); \
    if(GL){ NB0((t)+1,nbc); } \
    }while(0)
  int t=1;
  for(;t+5<NT;t+=2){
    STEP(pB0,pB1,pA0,pA1,t,true,true,true);     WAIT_BAR(2); RESC(); ROT();
    STEP(pA0,pA1,pB0,pB1,t+1,true,true,true);   WAIT_BAR(2); RESC(); ROT();
  }
  #undef CMASK
  #define CMASK(P0,P1,t) do{int jb_=3-(t); if(jb_>=0)cmask(P0,P1,jb_,qrel,hi);}while(0)
  #define ENDW(tt) do{ if((tt)+3<NT){WAIT_BAR(2);} else if((tt)+2<NT){WAIT_BAR(1);} else {WAIT_BAR(0);} }while(0)
  for(;t+1<NT;t+=2){
    STEP(pB0,pB1,pA0,pA1,t,(t+3<NT),(t+1<NT),(t+1<NT));       ENDW(t);   RESC(); ROT();
    STEP(pA0,pA1,pB0,pB1,t+1,(t+4<NT),(t+2<NT),(t+2<NT));     ENDW(t+1); RESC(); ROT();
  }
  STEP(pB0,pB1,pA0,pA1,NT-1,false,false,false); RESC();
  { float sacc=pB0[0]+pB0[1]; _Pragma("unroll") for(int r=2;r<16;++r)sacc+=pB0[r]; _Pragma("unroll") for(int r=0;r<16;++r)sacc+=pB1[r]; l_reg+=sacc;
    pw0=(u32x4){PKW(pB0,0),PKW(pB0,2),PKW(pB0,4),PKW(pB0,6)};pw1=(u32x4){PKW(pB0,8),PKW(pB0,10),PKW(pB0,12),PKW(pB0,14)};pw2=(u32x4){PKW(pB1,0),PKW(pB1,2),PKW(pB1,4),PKW(pB1,6)};pw3=(u32x4){PKW(pB1,8),PKW(pB1,10),PKW(pB1,12),PKW(pB1,14)};
    SBAR(); pv(o,vb0+sl_cur,PAF(0),PAF(1),PAF(2),PAF(3)); }
  #undef PKW
  #undef PAF
  #undef VFR
  #undef PIN
  #undef MX3
  #undef GAPA
  #undef GAPB
  #undef EX
  #undef VRD
  #undef KRD
  #undef STEP
  #undef ENDW
  {auto rr=__builtin_amdgcn_permlane32_swap(__float_as_uint(l_reg),__float_as_uint(l_reg),false,false);l_reg=__uint_as_float(rr[0])+__uint_as_float(rr[1]);}
  if(hi==0)wsf[32+r32]=l_reg;asm volatile("s_waitcnt lgkmcnt(0)":::"memory");
  float rli[16];
  #pragma unroll
  for(int r=0;r<16;++r)rli[r]=__builtin_amdgcn_rcpf(wsf[32+crow(r,hi)]);
  bf16*Ow=O+(rowbase+q0+wid*QBLK)*DM+h*D;
  { bf16*stg=(bf16*)(shm+LDS_OST)+wid*2048;
    #pragma unroll
    for(int r=0;r<16;++r){const int orow=crow(r,hi);
      #pragma unroll
      for(int d0=0;d0<2;++d0)stg[orow*64+d0*32+r32]=__float2bfloat16(o[d0][r]*rli[r]);}
    asm volatile("s_waitcnt lgkmcnt(0)":::"memory");
    #pragma unroll
    for(int i=0;i<4;++i){const int row=i*8+(lane>>3),ch=lane&7; const u32x4 v=*(const u32x4*)(stg+row*64+ch*8); ATTN_STORE16(Ow+(long)row*DM+ch*8,v);} }
  asm volatile("s_waitcnt lgkmcnt(0)\n\ts_barrier":::"memory");
  #undef DMA_K
  #undef DMA_V
  #undef NB0
  #undef NB1
  #undef CMASK
  #undef START
  #undef RESC
  #undef ROT
}
constexpr int ATTN_LDS_BYTES=LDS_BYTES;
#undef SBAR
#undef WAIT_BAR
}

#define LAS __attribute__((address_space(3)))
typedef unsigned short bf16_t;
typedef short bf16x8 __attribute__((ext_vector_type(8)));
typedef short s16x4 __attribute__((ext_vector_type(4)));
typedef float f32x4 __attribute__((ext_vector_type(4)));
typedef float f32x16 __attribute__((ext_vector_type(16)));
typedef unsigned u32x4 __attribute__((ext_vector_type(4)));
typedef unsigned u32x2 __attribute__((ext_vector_type(2)));

constexpr int DM = 1024, NBATCH = 32, SEQ = 2048, T = NBATCH * SEQ, DFF = 2752, DFFP = 2816, INCOLS = 3080, NMODC = 9 * DM;
constexpr int NWAVES = 8, NTHR = 512;
constexpr float EPS = 1e-6f, LOG2E = 1.4426950408889634f;
constexpr size_t MiB = 1u << 20;
constexpr size_t WS_WGU1 = 0, WS_WD1 = 11 * MiB, WS_WGU2 = 17 * MiB, WS_WD2 = 28 * MiB, WS_WIN = 34 * MiB, WS_WOUT = 40 * MiB, WS_MOD = 42 * MiB,
                 WS_ROPE = 44 * MiB, WS_FL = 48 * MiB, WS_KB = 50 * MiB, WS_LSE = 52 * MiB, WS_WF = 58 * MiB, WS_BAR = 59 * MiB,
                 WS_H = 64 * MiB, WS_Y = 192 * MiB, WS_BIG = 320 * MiB, WS_OA = 704 * MiB, WS_OB = 896 * MiB, WS_END = 960 * MiB;
constexpr size_t QKV_STRIDE = (size_t)T * 512;
constexpr int LDS_BYTES = 151552;

__device__ __forceinline__ float wave_sum(float v) {
#pragma unroll
    for (int o = 1; o < 64; o <<= 1) v += __shfl_xor(v, o);
    return v;
}
__device__ __forceinline__ unsigned pk2(float lo, float hi) { return pg8::cvt_pk_bf16(lo, hi); }
__device__ __forceinline__ float bf_lo(unsigned u) { return __uint_as_float(u << 16); }
__device__ __forceinline__ float bf_hi(unsigned u) { return __uint_as_float(u & 0xffff0000u); }
#define LDS_WAIT() asm volatile("s_waitcnt lgkmcnt(0)" ::: "memory")

__device__ __forceinline__ int opaque_tid() { int t = threadIdx.x; asm volatile("" : "+v"(t)); return t; }
__device__ __forceinline__ void tr_item(const float* __restrict__ W, int ldn, int k0, int n0, bf16_t* WT, int Kd, int drow0, LAS float* scr, int lane) {
#pragma unroll 8
    for (int i = 0; i < 32; ++i) { const int kk = 2 * i + (lane >> 5); scr[kk * 33 + (lane & 31)] = W[(size_t)(k0 + kk) * ldn + n0 + (lane & 31)]; }
    LDS_WAIT();
    const int c = lane & 7;
#pragma unroll
    for (int j = 0; j < 4; ++j) { const int n = (lane >> 3) + 8 * j; const LAS float* s = scr + (8 * c) * 33 + n;
        u32x4 o; o.x = pk2(s[0 * 33], s[1 * 33]); o.y = pk2(s[2 * 33], s[3 * 33]); o.z = pk2(s[4 * 33], s[5 * 33]); o.w = pk2(s[6 * 33], s[7 * 33]);
        *(u32x4*)(WT + (size_t)(drow0 + n) * Kd + k0 + 8 * c) = o; }
    LDS_WAIT();
}

struct Args { const float* in[22]; float* out; unsigned char* ws; };

__device__ __forceinline__ void p0_phase(const Args& a, LAS unsigned char* lds, int tid, int lane, int wave) {
    unsigned char* ws = a.ws;
    const int G = gridDim.x;
    {
        LAS float* sc = (LAS float*)lds;
        const float* c = a.in[1]; const float* wada = a.in[3]; const float* bada = a.in[4]; float* MOD = (float*)(ws + WS_MOD);
        for (int it = blockIdx.x; it < NMODC / 64; it += G) {
            __syncthreads();
            for (int e = tid; e < NBATCH * DM; e += NTHR) { const float v = c[e]; sc[e] = v / (1.0f + __expf(-v)); }
            __syncthreads();
            const int j = it * 64 + lane; const int kb = wave * 128;
            float acc[32];
#pragma unroll
            for (int b = 0; b < 32; ++b) acc[b] = 0.f;
            for (int k4 = 0; k4 < 128; k4 += 4) {
                const float w0 = wada[(size_t)(kb + k4 + 0) * NMODC + j], w1 = wada[(size_t)(kb + k4 + 1) * NMODC + j],
                            w2 = wada[(size_t)(kb + k4 + 2) * NMODC + j], w3 = wada[(size_t)(kb + k4 + 3) * NMODC + j];
#pragma unroll
                for (int b = 0; b < 32; ++b) { const f32x4 s = *(const LAS f32x4*)(sc + b * DM + kb + k4); acc[b] += s[0] * w0 + s[1] * w1 + s[2] * w2 + s[3] * w3; }
            }
            __syncthreads();
            LAS float* P = (LAS float*)lds;
#pragma unroll
            for (int b = 0; b < 32; ++b) P[(wave * 32 + b) * 64 + lane] = acc[b];
            __syncthreads();
            for (int o = tid; o < 32 * 64; o += NTHR) { const int b = o >> 6, col = o & 63; float s = 0.f;
#pragma unroll
                for (int w = 0; w < 8; ++w) s += P[(w * 32 + b) * 64 + col];
                MOD[(size_t)b * NMODC + it * 64 + col] = s + bada[it * 64 + col]; }
        }
        __syncthreads();
    }
    {
        LAS float* scr = (LAS float*)(lds + wave * 16384);
        const int gw = blockIdx.x * NWAVES + wave, NGW = G * NWAVES;
        constexpr int I_G = 16 * 86, I_D = 43 * 32, I_IN = 16 * 96, I_O = 16 * 32;
        constexpr int NITEMS = 2 * (2 * I_G + I_D) + I_IN + I_O;
        for (int it = gw; it < NITEMS; it += NGW) {
            int r = it; bool done = false;
#pragma unroll
            for (int f = 0; f < 2; ++f) {
                if (done) break;
                const float* Wg = a.in[f ? 19 : 7]; const float* Wu = a.in[f ? 20 : 8]; const float* Wd = a.in[f ? 21 : 9];
                bf16_t* WGU = (bf16_t*)(ws + (f ? WS_WGU2 : WS_WGU1)); bf16_t* WD = (bf16_t*)(ws + (f ? WS_WD2 : WS_WD1));
                if (r < 2 * I_G) { const int up = r >= I_G; const int q = up ? r - I_G : r; const int kb = q / 86, nb = q % 86, n0 = 32 * nb;
                    tr_item(up ? Wu : Wg, DFF, 64 * kb, n0, WGU, DM, 256 * (n0 >> 7) + (n0 & 127) + (up ? 128 : 0), scr, lane); done = true; continue; }
                r -= 2 * I_G;
                if (r < I_D) { const int kb = r / 32, nb = r % 32; tr_item(Wd, DM, 64 * kb, 32 * nb, WD, DFFP, 32 * nb, scr, lane); done = true; continue; }
                r -= I_D;
            }
            if (done) continue;
            if (r < I_IN) { const int kb = r / 96, nb = r % 96; tr_item(a.in[12], INCOLS, 64 * kb, 32 * nb, (bf16_t*)(ws + WS_WIN), DM, 32 * nb, scr, lane); continue; }
            r -= I_IN;
            { const int kb = r / 32, nb = r % 32; tr_item(a.in[16], DM, 64 * kb, 32 * nb, (bf16_t*)(ws + WS_WOUT), DM, 32 * nb, scr, lane); }
        }
    }
    {
        const int gt = blockIdx.x * NTHR + tid, NT = G * NTHR;
        for (int e = gt; e < 2 * 128 * 128; e += NT) { const int f = e >> 14, q = e & 16383, rr = q >> 7, ch = q & 127;
            bf16_t* WGU = (bf16_t*)(ws + (f ? WS_WGU2 : WS_WGU1)); const int row = 21 * 256 + (rr < 64 ? 64 + rr : 128 + rr);
            *(u32x4*)(WGU + (size_t)row * DM + ch * 8) = (u32x4){0u, 0u, 0u, 0u}; }
        for (int e = gt; e < 2 * 1024 * 8; e += NT) { const int f = e >> 13, q = e & 8191, row = q >> 3, ch = q & 7;
            bf16_t* WD = (bf16_t*)(ws + (f ? WS_WD2 : WS_WD1)); *(u32x4*)(WD + (size_t)row * DFFP + DFF + ch * 8) = (u32x4){0u, 0u, 0u, 0u}; }
        float* WF = (float*)(ws + WS_WF);
        for (int e = gt; e < 8 * DM; e += NT) { const int j = e >> 10, k = e & 1023; WF[e] = a.in[12][(size_t)k * INCOLS + 3072 + j]; }
        float* ROPE = (float*)(ws + WS_ROPE); const int* pos = (const int*)a.in[2];
        for (int e = gt; e < T * 8; e += NT) { const int row = e >> 3, i = e & 7; const float inv = exp2f(-(float)i * 0.125f * 18.931568569324174f);
            const float ang = (float)pos[row] * inv; ROPE[(size_t)row * 16 + i] = cosf(ang); ROPE[(size_t)row * 16 + 8 + i] = sinf(ang); }
    }
}

template <bool HAS_Y, bool HAS_H, bool HAS_FL>
__device__ __forceinline__ void rowpass(const float* xin, float* xout, const bf16_t* Y, bf16_t* H, float* FL, const float* g_post, const float* g_pre,
                                        const float* MOD, int gi, float gscale, int sci, int shi, LAS const float* wfl, int lane, int wave, int b0, int nbat) {
    constexpr int R = 4;
    const int gw = blockIdx.x * NWAVES + wave, NGW = gridDim.x * NWAVES;
    const int WPB = (NGW / nbat) > 0 ? (NGW / nbat) : 1; const int wb = b0 + gw / WPB, wj = gw % WPB;
    int cur_b = -1;
    f32x4 A[4], Bv[4], Cv[4];
#pragma unroll
    for (int j = 0; j < 4; ++j) { A[j] = (f32x4){0.f, 0.f, 0.f, 0.f}; Bv[j] = A[j]; Cv[j] = A[j]; }
    for (int lr = wj * R; lr < SEQ && wb < b0 + nbat; lr += WPB * R) {
        const int row0 = wb * SEQ + lr;
        const int b = wb;
        if (b != cur_b) { cur_b = b;
#pragma unroll
            for (int j = 0; j < 4; ++j) { const int c = 4 * lane + 256 * j;
                if (HAS_Y) A[j] = *(const f32x4*)(MOD + (size_t)b * NMODC + gi * DM + c) * *(const f32x4*)(g_post + c) * gscale;
                if (HAS_H) { Bv[j] = *(const f32x4*)(g_pre + c) * (*(const f32x4*)(MOD + (size_t)b * NMODC + sci * DM + c) + 1.0f); Cv[j] = *(const f32x4*)(MOD + (size_t)b * NMODC + shi * DM + c); } } }
        f32x4 x[R][4]; u32x2 yw[R][4];
#pragma unroll
        for (int q = 0; q < R; ++q)
#pragma unroll
            for (int j = 0; j < 4; ++j) { x[q][j] = __builtin_nontemporal_load((const f32x4*)(xin + (size_t)(row0 + q) * DM + 4 * lane + 256 * j));
                if (HAS_Y) yw[q][j] = __builtin_nontemporal_load((const u32x2*)(Y + (size_t)(row0 + q) * DM + 4 * lane + 256 * j)); }
        if (HAS_Y) {
            float ss[R];
#pragma unroll
            for (int q = 0; q < R; ++q) { ss[q] = 0.f;
#pragma unroll
                for (int j = 0; j < 4; ++j) { const float y0 = bf_lo(yw[q][j].x), y1 = bf_hi(yw[q][j].x), y2 = bf_lo(yw[q][j].y), y3 = bf_hi(yw[q][j].y); ss[q] += (y0 * y0 + y1 * y1) + (y2 * y2 + y3 * y3); } }
#pragma unroll
            for (int o = 1; o < 64; o <<= 1)
#pragma unroll
                for (int q = 0; q < R; ++q) ss[q] += __shfl_xor(ss[q], o);
#pragma unroll
            for (int q = 0; q < R; ++q) { const float rstd = 1.0f / sqrtf(ss[q] * (1.0f / DM) + EPS);
#pragma unroll
                for (int j = 0; j < 4; ++j) { const f32x4 y = {bf_lo(yw[q][j].x), bf_hi(yw[q][j].x), bf_lo(yw[q][j].y), bf_hi(yw[q][j].y)};
                    x[q][j] = x[q][j] + A[j] * (y * rstd); __builtin_nontemporal_store(x[q][j], (f32x4*)(xout + (size_t)(row0 + q) * DM + 4 * lane + 256 * j)); } }
        }
        if (HAS_H) {
            float ss[R];
#pragma unroll
            for (int q = 0; q < R; ++q) { ss[q] = 0.f;
#pragma unroll
                for (int j = 0; j < 4; ++j) ss[q] += (x[q][j][0] * x[q][j][0] + x[q][j][1] * x[q][j][1]) + (x[q][j][2] * x[q][j][2] + x[q][j][3] * x[q][j][3]); }
#pragma unroll
            for (int o = 1; o < 64; o <<= 1)
#pragma unroll
                for (int q = 0; q < R; ++q) ss[q] += __shfl_xor(ss[q], o);
#pragma unroll
            for (int q = 0; q < R; ++q) { const float rstd = 1.0f / sqrtf(ss[q] * (1.0f / DM) + EPS);
                f32x4 h[4];
#pragma unroll
                for (int j = 0; j < 4; ++j) { h[j] = (x[q][j] * rstd) * Bv[j] + Cv[j];
                    u32x2 w; w.x = pk2(h[j][0], h[j][1]); w.y = pk2(h[j][2], h[j][3]); *(u32x2*)(H + (size_t)(row0 + q) * DM + 4 * lane + 256 * j) = w; }
                if (HAS_FL) {
                    float myv = 0.f;
#pragma unroll
                    for (int f = 0; f < 8; ++f) { float d = 0.f;
#pragma unroll
                        for (int j = 0; j < 4; ++j) { const f32x4 wv = *(const LAS f32x4*)(wfl + f * DM + 4 * lane + 256 * j); d += (h[j][0] * wv[0] + h[j][1] * wv[1]) + (h[j][2] * wv[2] + h[j][3] * wv[3]); }
                        d = wave_sum(d); if (lane == f) myv = d; }
                    if (lane < 8) FL[(size_t)(row0 + q) * 8 + lane] = myv;
                }
            }
        }
    }
}

namespace att {
constexpr int KP = 144;
constexpr float C2 = 0.125f * 1.4426950408889634f;
#define MFMA32(a, b, c) __builtin_amdgcn_mfma_f32_32x32x16_bf16((a), (b), (c), 0, 0, 0)
__device__ __forceinline__ s16x4 vtr(LAS const unsigned char* p) { return __builtin_bit_cast(s16x4, __builtin_amdgcn_ds_read_tr16_b64_v4i16((LAS s16x4*)p)); }
__device__ __forceinline__ bf16x8 pack8(const f32x16& x, int s) {
    u32x4 p; p.x = pk2(x[8 * s + 0], x[8 * s + 1]); p.y = pk2(x[8 * s + 2], x[8 * s + 3]); p.z = pk2(x[8 * s + 4], x[8 * s + 5]); p.w = pk2(x[8 * s + 6], x[8 * s + 7]);
    return __builtin_bit_cast(bf16x8, p);
}
template <int NKB, bool M0, bool M1, bool BIAS>
__device__ __forceinline__ void step(LAS const unsigned char* kbuf, LAS const unsigned char* vbuf, LAS const float* kbias, const bf16x8 (&qf)[4], f32x16 (&o)[2], float& m, float& l,
                                     int lo0, int hi0, int lo1, int hi1, int r, int h, int lane) {
    f32x16 s[NKB];
#pragma unroll
    for (int kb = 0; kb < NKB; ++kb) {
#pragma unroll
        for (int i = 0; i < 16; ++i) s[kb][i] = 0.f;
#pragma unroll
        for (int ss = 0; ss < 4; ++ss) { const bf16x8 kf = *(const LAS bf16x8*)(kbuf + (32 * kb + r) * KP + 32 * ss + 16 * h); s[kb] = MFMA32(kf, qf[ss], s[kb]); }
    }
    float mx = -INFINITY;
#pragma unroll
    for (int kb = 0; kb < NKB; ++kb) {
        const bool MK = kb == 0 ? M0 : M1; const int lo = (kb == 0 ? lo0 : lo1) - 4 * h, hi = (kb == 0 ? hi0 : hi1) - 4 * h; const unsigned span = (unsigned)(hi - lo);
#pragma unroll
        for (int g = 0; g < 4; ++g) {
            f32x4 bv = {0.f, 0.f, 0.f, 0.f};
            if (BIAS) bv = *(const LAS f32x4*)(kbias + 32 * kb + 8 * g + 4 * h);
#pragma unroll
            for (int j = 0; j < 4; ++j) { const int i = 4 * g + j; float v = s[kb][i] * C2 + bv[j];
                if (MK) { const int c = j + 8 * g; v = ((unsigned)(c - lo) <= span && hi >= lo) ? v : -INFINITY; }
                s[kb][i] = v; mx = fmaxf(mx, v); }
        }
    }
    mx = fmaxf(mx, __shfl_xor(mx, 32));
    const float mn = fmaxf(m, mx); const float alpha = __builtin_amdgcn_exp2f(m - mn); m = mn;
    float ps = 0.f;
#pragma unroll
    for (int kb = 0; kb < NKB; ++kb)
#pragma unroll
        for (int i = 0; i < 16; ++i) { const float p = __builtin_amdgcn_exp2f(s[kb][i] - mn); s[kb][i] = p; ps += p; }
    l = l * alpha + ps;
#pragma unroll
    for (int i = 0; i < 16; ++i) { o[0][i] *= alpha; o[1][i] *= alpha; }
    const int q4 = (lane & 15) >> 2, p4 = lane & 3, blk = (lane >> 4) & 1;
    LAS const unsigned char* vb = vbuf + (4 * h + q4) * KP + 32 * blk + 8 * p4;
#pragma unroll
    for (int kb = 0; kb < NKB; ++kb)
#pragma unroll
        for (int s2 = 0; s2 < 2; ++s2) { const bf16x8 pf = pack8(s[kb], s2);
#pragma unroll
            for (int db = 0; db < 2; ++db) { const s16x4 a0 = vtr(vb + (32 * kb + 16 * s2) * KP + 64 * db), a1 = vtr(vb + (32 * kb + 16 * s2 + 8) * KP + 64 * db);
                const bf16x8 vf = __builtin_shufflevector(a0, a1, 0, 1, 2, 3, 4, 5, 6, 7); o[db] = MFMA32(vf, pf, o[db]); } }
}
__device__ __forceinline__ float finish(f32x16 (&o)[2], float l, bf16_t* orow, int h) {
    const float lt = l + __shfl_xor(l, 32); const float inv = 1.0f / lt;
#pragma unroll
    for (int db = 0; db < 2; ++db)
#pragma unroll
        for (int g = 0; g < 4; ++g) { u32x2 w; w.x = pk2(o[db][4 * g + 0] * inv, o[db][4 * g + 1] * inv); w.y = pk2(o[db][4 * g + 2] * inv, o[db][4 * g + 3] * inv);
            *(u32x2*)(orow + 32 * db + 8 * g + 4 * h) = w; }
    return lt;
}

__device__ __forceinline__ void a_phase(const bf16_t* Q, const bf16_t* K, const bf16_t* V, bf16_t* OA, float* LSE, LAS unsigned char* lds, int tid, int lane, int wave, int b0, int nbat) {
    const int r = lane & 31, h = lane >> 5, half = wave >> 2, w4 = wave & 3, t256 = tid & 255;
    LAS unsigned char* kbase = lds + half * (2 * 256 * KP); LAS unsigned char* vbase = kbase + 256 * KP;
    for (int it = blockIdx.x; it < nbat * 8 * 24; it += gridDim.x) {
        const int su = b0 * 8 * 48 + 2 * it + half; const int bh = su / 48, u = su % 48, p = u >> 4, v = u & 15, b = bh >> 3, hd = bh & 7;
        const int d = (p == 0) ? 1 : (p == 1 ? 4 : 16); const int cls = (p == 0) ? 0 : (p == 1 ? (v >> 2) : v); const int n = (p == 0) ? v : (p == 1 ? (v & 3) : 0);
        __syncthreads();
#pragma unroll
        for (int bt = 0; bt < 2; ++bt) {
            u32x4 kr[4], vr[4];
#pragma unroll
            for (int i = 0; i < 4; ++i) { const int idx = t256 + 256 * (4 * bt + i); const int j = idx >> 3, ch = idx & 7; const int mk = 128 * n - 128 + j;
                if (mk >= 0) { const size_t row = (size_t)b * SEQ + mk * d + cls; kr[i] = *(const u32x4*)(K + row * 512 + hd * 64 + ch * 8); vr[i] = *(const u32x4*)(V + row * 512 + hd * 64 + ch * 8); }
                else { kr[i] = (u32x4){0u, 0u, 0u, 0u}; vr[i] = kr[i]; } }
#pragma unroll
            for (int i = 0; i < 4; ++i) { const int idx = t256 + 256 * (4 * bt + i); const int j = idx >> 3, ch = idx & 7;
                *(LAS u32x4*)(kbase + j * KP + ch * 16) = kr[i]; *(LAS u32x4*)(vbase + j * KP + ch * 16) = vr[i]; }
        }
        const int mq = 128 * n + 32 * w4 + r; const size_t qrow = (size_t)b * SEQ + mq * d + cls;
        bf16x8 qf[4];
#pragma unroll
        for (int ss = 0; ss < 4; ++ss) qf[ss] = *(const bf16x8*)(Q + qrow * 512 + hd * 64 + 16 * ss + 8 * h);
        __syncthreads();
        f32x16 o[2];
#pragma unroll
        for (int i = 0; i < 16; ++i) { o[0][i] = 0.f; o[1][i] = 0.f; }
        float m = -1e30f, l = 0.f;
        const int jlo = (n == 0) ? max(32 * w4 + r, 128) : 32 * w4 + r, jhi = 128 + 32 * w4 + r;
        LAS const unsigned char* kw = kbase + 32 * w4 * KP; LAS const unsigned char* vw = vbase + 32 * w4 * KP;
        if (n > 0) {
            step<2, true, false, false>(kw, vw, nullptr, qf, o, m, l, r, 31, 0, 31, r, h, lane);
            step<2, false, false, false>(kw + 64 * KP, vw + 64 * KP, nullptr, qf, o, m, l, 0, 0, 0, 0, r, h, lane);
        } else {
            if (w4 + 1 >= 4) step<2, true, true, false>(kw, vw, nullptr, qf, o, m, l, jlo - 32 * w4, jhi - 32 * w4, jlo - 32 * (w4 + 1), jhi - 32 * (w4 + 1), r, h, lane);
            if (w4 + 3 >= 4) step<2, true, true, false>(kw + 64 * KP, vw + 64 * KP, nullptr, qf, o, m, l, jlo - 32 * (w4 + 2), jhi - 32 * (w4 + 2), jlo - 32 * (w4 + 3), jhi - 32 * (w4 + 3), r, h, lane);
        }
        step<1, true, false, false>(kw + 128 * KP, vw + 128 * KP, nullptr, qf, o, m, l, jlo - 32 * (w4 + 4), jhi - 32 * (w4 + 4), 0, 0, r, h, lane);
        const float lt = finish(o, l, OA + ((size_t)p * T + qrow) * 512 + hd * 64, h);
        if (h == 0) LSE[((size_t)p * T + qrow) * 8 + hd] = m + __log2f(lt);
    }
    __syncthreads();
}
}


__device__ __forceinline__ void b_phase2(const bf16_t* Q, const bf16_t* K, const bf16_t* V, const float* KBIAS, bf16_t* O, unsigned char* shm, int tid, int b0, int nbat) {
    for (int it = blockIdx.x; it < nbat * 8 * 2; it += gridDim.x) {
        const int bh = b0 * 8 + (it >> 1), set = it & 1;
        const int t2 = opaque_tid();
        const f32x4 v = *(const f32x4*)(KBIAS + (size_t)bh * SEQ + 4 * t2);
        *(LAS f32x4*)((LAS unsigned char*)shm + attn_body::LDS_KB + 16 * t2) = v;
        __syncthreads();
        for (int k = 0; k < 4; ++k) { const int qb = (k & 1) ? (2 * (k >> 1) + set) : (7 - 2 * (k >> 1) - set);
            attn_body::attn_unit<8>(bh >> 3, bh & 7, qb, (const attn_body::bf16*)Q, (const attn_body::bf16*)K, (const attn_body::bf16*)V, (attn_body::bf16*)O, (char*)shm); }
    }
    __syncthreads();
}

__device__ __forceinline__ void merge_pass(const bf16_t* OA, const float* LSE, const bf16_t* OB, const float* g_a, const float* g_b, bf16_t* MG, int lane, int wave, int r0, int nrows) {
    constexpr int R = 4;
    const int gw = blockIdx.x * NWAVES + wave, NGW = gridDim.x * NWAVES;
    f32x4 ga0 = *(const f32x4*)(g_a + 8 * lane), ga1 = *(const f32x4*)(g_a + 8 * lane + 4), gb0 = *(const f32x4*)(g_b + 8 * lane), gb1 = *(const f32x4*)(g_b + 8 * lane + 4);
    const int hd = lane >> 3;
    for (int rowb = r0 + gw * R; rowb < r0 + nrows; rowb += NGW * R) {
        float ls[R][3]; u32x4 w[R][3], wb[R];
#pragma unroll
        for (int q = 0; q < R; ++q) { const int row = rowb + q;
#pragma unroll
            for (int p = 0; p < 3; ++p) { ls[q][p] = LSE[((size_t)p * T + row) * 8 + hd]; w[q][p] = *(const u32x4*)(OA + ((size_t)p * T + row) * 512 + 8 * lane); }
            wb[q] = *(const u32x4*)(OB + (size_t)row * 512 + 8 * lane); }
        float va[R][8], vb[R][8], sa[R], sb[R];
#pragma unroll
        for (int q = 0; q < R; ++q) {
            const float mx = fmaxf(ls[q][0], fmaxf(ls[q][1], ls[q][2]));
            float e[3]; e[0] = __builtin_amdgcn_exp2f(ls[q][0] - mx); e[1] = __builtin_amdgcn_exp2f(ls[q][1] - mx); e[2] = __builtin_amdgcn_exp2f(ls[q][2] - mx);
            const float inv = 1.0f / (e[0] + e[1] + e[2]);
#pragma unroll
            for (int k = 0; k < 4; ++k) {
                float lo = 0.f, hi = 0.f;
#pragma unroll
                for (int p = 0; p < 3; ++p) { lo += e[p] * bf_lo(w[q][p][k]); hi += e[p] * bf_hi(w[q][p][k]); }
                va[q][2 * k] = lo * inv; va[q][2 * k + 1] = hi * inv; vb[q][2 * k] = bf_lo(wb[q][k]); vb[q][2 * k + 1] = bf_hi(wb[q][k]);
            }
            sa[q] = 0.f; sb[q] = 0.f;
#pragma unroll
            for (int k = 0; k < 8; ++k) { sa[q] += va[q][k] * va[q][k]; sb[q] += vb[q][k] * vb[q][k]; }
        }
#pragma unroll
        for (int o = 1; o < 64; o <<= 1)
#pragma unroll
            for (int q = 0; q < R; ++q) { sa[q] += __shfl_xor(sa[q], o); sb[q] += __shfl_xor(sb[q], o); }
#pragma unroll
        for (int q = 0; q < R; ++q) { const int row = rowb + q;
            const float ra = 1.0f / sqrtf(sa[q] * (1.0f / 512.0f) + EPS), rb = 1.0f / sqrtf(sb[q] * (1.0f / 512.0f) + EPS);
            u32x4 oa, ob;
            oa.x = pk2(va[q][0] * ra * ga0[0], va[q][1] * ra * ga0[1]); oa.y = pk2(va[q][2] * ra * ga0[2], va[q][3] * ra * ga0[3]); oa.z = pk2(va[q][4] * ra * ga1[0], va[q][5] * ra * ga1[1]); oa.w = pk2(va[q][6] * ra * ga1[2], va[q][7] * ra * ga1[3]);
            ob.x = pk2(vb[q][0] * rb * gb0[0], vb[q][1] * rb * gb0[1]); ob.y = pk2(vb[q][2] * rb * gb0[2], vb[q][3] * rb * gb0[3]); ob.z = pk2(vb[q][4] * rb * gb1[0], vb[q][5] * rb * gb1[1]); ob.w = pk2(vb[q][6] * rb * gb1[2], vb[q][7] * rb * gb1[3]);
            *(u32x4*)(MG + (size_t)row * DM + 8 * lane) = oa; *(u32x4*)(MG + (size_t)row * DM + 512 + 8 * lane) = ob; }
    }
}

__device__ __forceinline__ void cumsum_phase(const float* FL, const float* bforget, float* KBIAS, LAS unsigned char* lds, int tid, int lane, int wave, int b0, int nbat) {
    LAS float* wt = (LAS float*)lds;
    for (int it = b0 * 8 + blockIdx.x; it < (b0 + nbat) * 8; it += gridDim.x) {
        const int b = it >> 3, hd = it & 7; const float bf = bforget[hd];
        float v[4];
#pragma unroll
        for (int i = 0; i < 4; ++i) { const float z = FL[((size_t)b * SEQ + 4 * tid + i) * 8 + hd] + bf; v[i] = fminf(z, 0.f) - log1pf(__expf(-fabsf(z))); }
        v[1] += v[0]; v[2] += v[1]; v[3] += v[2];
        float sc = v[3];
#pragma unroll
        for (int o = 1; o < 64; o <<= 1) { const float t = __shfl_up(sc, o); if (lane >= o) sc += t; }
        __syncthreads();
        if (lane == 63) wt[wave] = sc;
        __syncthreads();
        float off = sc - v[3];
        for (int w = 0; w < wave; ++w) off += wt[w];
        f32x4 o4 = {-(off + v[0]) * LOG2E, -(off + v[1]) * LOG2E, -(off + v[2]) * LOG2E, -(off + v[3]) * LOG2E};
        *(f32x4*)(KBIAS + (size_t)it * SEQ + 4 * tid) = o4;
    }
    __syncthreads();
}

#define XB_TMO      128
#define XB_XCNT(j)  (256  + 64 * (j))
#define XB_XSUB(j)  (1280 + 64 * (j))
#define XB_XGEN(j)  (2304 + 64 * (j))
#define XB_TOP      3328
#define XB_TOPGEN   3392
#define XCD_BAR_WORDS 3456
#define XB_SPIN_CAP (1u << 18)

__device__ __forceinline__ unsigned xb_ld(unsigned* p)              { return __hip_atomic_load(p, __ATOMIC_RELAXED, __HIP_MEMORY_SCOPE_AGENT); }
__device__ __forceinline__ unsigned xb_add(unsigned* p, unsigned v) { return __hip_atomic_fetch_add(p, v, __ATOMIC_RELAXED, __HIP_MEMORY_SCOPE_AGENT); }
__device__ __forceinline__ unsigned xb_xcc_id() { return (unsigned)__builtin_amdgcn_s_getreg((3 << 11) | 20) & 0xFu; }
#define XB_SPIN(cond, bar) do { unsigned _sp = 0; while (cond) { __builtin_amdgcn_s_sleep(1); \
    if ((++_sp & 255u) == 0u) { if (xb_ld(&(bar)[XB_TMO])) break; if (_sp > XB_SPIN_CAP) { atomicAdd(&(bar)[XB_TMO], 1u); break; } } } } while (0)

struct XcdBarrier {
    unsigned* bar; unsigned x;
    volatile LAS unsigned* st;
};

__device__ __forceinline__ XcdBarrier xcd_barrier_post(unsigned* bar, volatile LAS unsigned* st) {
    XcdBarrier b; b.bar = bar; b.x = xb_xcc_id(); b.st = st;
    if (threadIdx.x == 0) (void)xb_add(&bar[XB_XCNT(b.x)], 1u);
    return b;
}
__device__ __forceinline__ void xcd_barrier_complete(unsigned* bar, unsigned x, unsigned& nloc, unsigned& nx) {
    const unsigned G = gridDim.x * gridDim.y * gridDim.z;
    unsigned sum, cnt, mine, sp = 0u;
    for (;;) {
        sum = 0u; cnt = 0u; mine = 0u;
#pragma unroll
        for (unsigned j = 0; j < 16; ++j) { const unsigned c = xb_ld(&bar[XB_XCNT(j)]); sum += c; cnt += (c > 0u) ? 1u : 0u; mine = (j == x) ? c : mine; }
        if (sum == G) break;
        __builtin_amdgcn_s_sleep(1);
        if ((++sp & 255u) == 0u) { if (xb_ld(&bar[XB_TMO])) break; if (sp > XB_SPIN_CAP) { atomicAdd(&bar[XB_TMO], 1u); break; } }
    }
    nloc = mine > 0u ? mine : 1u; nx = cnt > 0u ? cnt : 1u;
}

__device__ __forceinline__ void xcd_barrier(const XcdBarrier& b) {
    asm volatile("s_waitcnt vmcnt(0)" ::: "memory");
    __syncthreads();
    if (threadIdx.x == 0) {
        unsigned* bar = b.bar;
        __builtin_amdgcn_s_waitcnt(0);
        unsigned nloc = b.st[0], nx = b.st[1];
        if (nloc == 0u) { xcd_barrier_complete(bar, b.x, nloc, nx); b.st[0] = nloc; b.st[1] = nx; }
        const unsigned old = xb_add(&bar[XB_XSUB(b.x)], 1u);
        const unsigned gen = old / nloc;
        if (old + 1u == (gen + 1u) * nloc) {
            __builtin_amdgcn_fence(__ATOMIC_RELEASE, "agent");
            asm volatile("s_waitcnt vmcnt(0)" ::: "memory");
            const unsigned og = xb_add(&bar[XB_TOP], 1u);
            const unsigned tg = og / nx;
            if (og + 1u == (tg + 1u) * nx) xb_add(&bar[XB_TOPGEN], 1u);
            else XB_SPIN(xb_ld(&bar[XB_TOPGEN]) == tg, bar);
            __builtin_amdgcn_fence(__ATOMIC_ACQUIRE, "agent");
            xb_add(&bar[XB_XGEN(b.x)], 1u);
            asm volatile("s_waitcnt vmcnt(0)" ::: "memory");
        } else {
            XB_SPIN(xb_ld(&bar[XB_XGEN(b.x)]) == gen, bar);
            __builtin_amdgcn_fence(__ATOMIC_ACQUIRE, "agent");
            asm volatile("s_waitcnt vmcnt(0)" ::: "memory");
        }
    }
    __syncthreads();
}

__global__ void __launch_bounds__(NTHR, 2) mega_fwd(Args a) {
    extern __shared__ __attribute__((aligned(16))) unsigned char lds_raw[];
    LAS unsigned char* lds = (LAS unsigned char*)lds_raw;
    cg::grid_group grid = cg::this_grid();
#define IDS() const int tid = opaque_tid(), lane = tid & 63, wave = __builtin_amdgcn_readfirstlane(tid >> 6); (void)lane; (void)wave
    unsigned char* ws = a.ws;
    bf16_t* H = (bf16_t*)(ws + WS_H); bf16_t* Y = (bf16_t*)(ws + WS_Y); bf16_t* HID = (bf16_t*)(ws + WS_BIG); bf16_t* QKV = (bf16_t*)(ws + WS_BIG);
    bf16_t* OA = (bf16_t*)(ws + WS_OA); bf16_t* OB = (bf16_t*)(ws + WS_OB);
    float* MOD = (float*)(ws + WS_MOD); float* FL = (float*)(ws + WS_FL); float* KBIAS = (float*)(ws + WS_KB); float* LSE = (float*)(ws + WS_LSE);
    const float* x = a.in[0]; float* out = a.out;
    const int G = gridDim.x, cb = blockIdx.x;

    volatile LAS unsigned* bst = (volatile LAS unsigned*)(lds + 151040);
    unsigned* barw = (unsigned*)(ws + WS_BAR);
    { IDS();
    if (tid < 2) bst[tid] = 0u;
    if (blockIdx.x == 0) for (int i = tid; i < XCD_BAR_WORDS; i += NTHR) barw[i] = 0u; }
    { IDS(); p0_phase(a, lds, tid, lane, wave); }
    grid.sync();
    const XcdBarrier bar = xcd_barrier_post(barw, bst);
    for (int st = 1; st <= 13; ++st) {
        const bool r0job = (st == 1 || st == 4 || st == 7 || st == 9 || st == 12);
        const bool r1job = (st == 2 || st == 5 || st == 8 || st == 10 || st == 13);
        const bool odd = (blockIdx.x & 1) != 0;
        const int first = r0job ? (odd ? 0 : 1) : (r1job ? (odd ? 1 : 0) : 0);
        for (int kk = 0; kk < 2; ++kk) {
            const int grp = kk == 0 ? first : 1 - first; const int ph = st - grp;
            if (ph < 1 || ph > 12) continue;
            const int b0 = grp * (NBATCH / 2); const size_t r0 = (size_t)grp * (T / 2); constexpr int NB2 = NBATCH / 2, M2 = T / 2;
            if (ph == 1) { IDS(); rowpass<false, true, false>(x, nullptr, nullptr, H, nullptr, nullptr, a.in[5], MOD, 0, 0.f, 1, 0, nullptr, lane, wave, b0, NB2); }
            else if (ph == 2 || ph == 10) { const bool f2 = ph == 10;
                pg8::Gemm g{H + r0 * DM, (const bf16_t*)(ws + (f2 ? WS_WGU2 : WS_WGU1)), M2, 2 * DFFP, DM}; pg8::StaticOrder S; S.init(M2, 2 * DFFP, G, cb); pg8::EpiSwiglu E{HID + r0 * DFFP, DFFP};
                pg8::gemm_phase<pg8::EpiSwiglu, pg8::StaticOrder, true, true>(lds, g, S, E); }
            else if (ph == 3 || ph == 8 || ph == 11) { const bool o = ph == 8;
                pg8::Gemm g{o ? H + r0 * DM : HID + r0 * DFFP, (const bf16_t*)(ws + (o ? WS_WOUT : (ph == 3 ? WS_WD1 : WS_WD2))), M2, DM, o ? DM : DFFP}; pg8::StaticOrder S; S.init(M2, DM, G, cb); pg8::EpiPlain E{Y + r0 * DM, DM};
                pg8::gemm_phase<pg8::EpiPlain, pg8::StaticOrder, true, true>(lds, g, S, E); }
            else if (ph == 4) { IDS(); LAS float* wfl = (LAS float*)lds; const float* WF = (const float*)(ws + WS_WF);
                for (int e = tid; e < 8 * DM; e += NTHR) wfl[e] = WF[e];
                __syncthreads();
                rowpass<true, true, true>(x, out, Y, H, FL, a.in[6], a.in[10], MOD, 2, 0.5f, 4, 3, wfl, lane, wave, b0, NB2);
                __syncthreads(); }
            else if (ph == 5) { { IDS(); cumsum_phase(FL, a.in[13], KBIAS, lds, tid, lane, wave, b0, NB2); }
                pg8::Gemm g{H + r0 * DM, (const bf16_t*)(ws + WS_WIN), M2, 3072, DM}; pg8::StaticOrder S; S.init(M2, 3072, G, cb); pg8::EpiQKV E{QKV + r0 * 512, QKV_STRIDE, (const float*)(ws + WS_ROPE) + r0 * 16};
                pg8::gemm_phase<pg8::EpiQKV, pg8::StaticOrder, true, true>(lds, g, S, E); }
            else if (ph == 6) { { IDS(); b_phase2(QKV + 3 * QKV_STRIDE, QKV + 4 * QKV_STRIDE, QKV + 5 * QKV_STRIDE, KBIAS, OB, lds_raw, tid, b0, NB2); }
                { IDS(); att::a_phase(QKV, QKV + QKV_STRIDE, QKV + 2 * QKV_STRIDE, OA, LSE, lds, tid, lane, wave, b0, NB2); } }
            else if (ph == 7) { IDS(); merge_pass(OA, LSE, OB, a.in[14], a.in[15], H, lane, wave, (int)r0, M2); }
            else if (ph == 9) { IDS(); rowpass<true, true, false>(out, out, Y, H, nullptr, a.in[11], a.in[17], MOD, 5, 1.0f, 7, 6, nullptr, lane, wave, b0, NB2); }
            else { IDS(); rowpass<true, false, false>(out, out, Y, nullptr, nullptr, a.in[18], nullptr, MOD, 8, 0.5f, 0, 0, nullptr, lane, wave, b0, NB2); }
        }
        if (st < 13) xcd_barrier(bar);
    }
}

extern "C" void kernel_launch(void* const* d_in, const int* in_sizes, int n_in, void* d_out, int out_size, void* d_ws, size_t ws_size, hipStream_t stream) {
    static int grid = 0;
    if (grid == 0) {
        if (n_in != 22 || in_sizes[0] != T * DM || out_size != T * DM || ws_size < WS_END) { fprintf(stderr, "kernel_launch: unexpected shapes (n_in %d, ws %zu)\n", n_in, ws_size); grid = -1; return; }
        int dev = 0, cus = 0, per_cu = 0;
        (void)hipGetDevice(&dev); (void)hipDeviceGetAttribute(&cus, hipDeviceAttributeMultiprocessorCount, dev);
        if (hipFuncSetAttribute((const void*)mega_fwd, hipFuncAttributeMaxDynamicSharedMemorySize, LDS_BYTES) != hipSuccess) { fprintf(stderr, "kernel_launch: hipFuncSetAttribute failed\n"); grid = -1; return; }
        if (hipOccupancyMaxActiveBlocksPerMultiprocessor(&per_cu, (const void*)mega_fwd, NTHR, LDS_BYTES) != hipSuccess || per_cu < 1) { fprintf(stderr, "kernel_launch: occupancy query says %d\n", per_cu); per_cu = 1; }
        (void)hipGetLastError();
        grid = cus;
    }
    if (grid < 0) return;
    Args a{};
    for (int i = 0; i < 22; ++i) a.in[i] = (const float*)d_in[i];
    a.out = (float*)d_out; a.ws = (unsigned char*)d_ws;
    void* args[] = {&a};
    hipError_t e = hipLaunchCooperativeKernel((const void*)mega_fwd, dim3(grid), dim3(NTHR), args, LDS_BYTES, stream);
    if (e != hipSuccess) fprintf(stderr, "kernel_launch: cooperative launch failed: %s (grid %d)\n", hipGetErrorString(e), grid);
}
```

```cpp
#include <hip/hip_runtime.h>
#include <hip/hip_cooperative_groups.h>
#include <cstdio>
#include <cstdint>
namespace cg = cooperative_groups;
namespace pg8 {
#define PG8_LAS __attribute__((address_space(3)))
typedef unsigned short bf16_t;
typedef short bf16x8 __attribute__((ext_vector_type(8)));
typedef float f32x4 __attribute__((ext_vector_type(4)));
typedef unsigned u32x4 __attribute__((ext_vector_type(4)));
constexpr int BM = 256, BK = 64, HALF = 128, HTB = HALF * BK * 2  , STAGE_BYTES = 8 * HTB, NXCD = 8, WGM = 4;

__host__ __device__ __forceinline__ int lds_byte(int r, int c) { const int st = (r >> 4) * 2 + (c >> 5), rr = r & 15, cc = c & 31, ob = rr * 64 + cc * 2; return st * 1024 + (ob ^ (((ob >> 9) & 1) << 5)); }
__host__ __device__ __forceinline__ void stage_rc(int b, int& R, int& C) { const int st = b / 1024, sb = b % 1024, swz = sb ^ (((sb >> 9) & 1) << 5); R = (st >> 1) * 16 + swz / 64; C = (st & 1) * 32 + (swz % 64) / 2; }
__host__ __device__ __forceinline__ int perm32(int rho) { const int n = rho >> 4, i = rho & 15; return 8 * (i >> 2) + 4 * n + (i & 3); }

struct Unit { int pm, pn; };
struct Gemm { const bf16_t* A; const bf16_t* Bt; int M, N, K; };

struct StaticOrder {
    int nM, nN, nwg, G, c;
    __host__ __device__ void init(int M, int N, int G_, int c_) { nM = M / BM; nN = N / BM; nwg = nM * nN; G = G_; c = c_; }
    __host__ __device__ bool next(int i, Unit& u) const {
        const long L = (long)i * G + c; if (L >= nwg) return false;
        int wgid = (int)L; { const int q = nwg / NXCD, r = nwg % NXCD, xcd = wgid % NXCD, off = wgid / NXCD; wgid = (xcd < r ? xcd * (q + 1) : r * (q + 1) + (xcd - r) * q) + off; }
        const int nig = WGM * nN, gid = wgid / nig, fm = gid * WGM, gsz = (nM - fm) < WGM ? (nM - fm) : WGM;
        u.pm = fm + ((wgid % nig) % gsz); u.pn = (wgid % nig) / gsz; return true;
    }
    __device__ __forceinline__ void a_ready(const Unit&) const {}
    __device__ __forceinline__ void done(const Unit&) const {}
};


__device__ __forceinline__ unsigned cvt_pk_bf16(float lo, float hi) { unsigned r; asm volatile("v_cvt_pk_bf16_f32 %0, %1, %2" : "=v"(r) : "v"(lo), "v"(hi)); return r; }
typedef unsigned u32x4 __attribute__((ext_vector_type(4)));

struct EpiPlain {
    static constexpr bool PERM = true, AFTER_DRAIN = false;
    bf16_t* O; int ldc;
    __device__ __forceinline__ void operator()(const f32x4 (&acc)[2][2][4][2], const Unit& u, int wr, int wc, int fr, int fq) const {
        const int row0 = u.pm * BM + wr * 64 + fr; const int col0 = u.pn * BM + wc * 32 + 8 * fq;
#pragma unroll
        for (int ai = 0; ai < 2; ++ai)
#pragma unroll
            for (int m = 0; m < 4; ++m) { bf16_t* rowp = O + (size_t)(row0 + ai * HALF + m * 16) * ldc + col0;
#pragma unroll
                for (int bj = 0; bj < 2; ++bj) { const f32x4 v0 = acc[ai][bj][m][0], v1 = acc[ai][bj][m][1];
                    u32x4 w; w.x = cvt_pk_bf16(v0[0], v0[1]); w.y = cvt_pk_bf16(v0[2], v0[3]); w.z = cvt_pk_bf16(v1[0], v1[1]); w.w = cvt_pk_bf16(v1[2], v1[3]);
                    *(u32x4*)(rowp + bj * HALF) = w; } }
    }
};
typedef float f32x2 __attribute__((ext_vector_type(2)));
__device__ __forceinline__ f32x2 silu_mul_pk(f32x2 g, f32x2 u) {
    const f32x2 t = g * (-1.4426950408889634f);
    f32x2 e; e.x = __builtin_amdgcn_exp2f(t.x); e.y = __builtin_amdgcn_exp2f(t.y);
    const f32x2 d = e + 1.0f;
    f32x2 r; r.x = __builtin_amdgcn_rcpf(d.x); r.y = __builtin_amdgcn_rcpf(d.y);
    return (g * u) * r;
}
__device__ __forceinline__ unsigned silu_pk_bf16(float g0, float g1, float u0, float u1) { const f32x2 h = silu_mul_pk((f32x2){g0, g1}, (f32x2){u0, u1}); return cvt_pk_bf16(h.x, h.y); }
struct EpiSwiglu {
    static constexpr bool PERM = true, AFTER_DRAIN = false;
    bf16_t* O; int ldc;
    __device__ __forceinline__ void operator()(const f32x4 (&acc)[2][2][4][2], const Unit& u, int wr, int wc, int fr, int fq) const {
        const int row0 = u.pm * BM + wr * 64 + fr; const int col0 = u.pn * HALF + wc * 32 + 8 * fq;
#pragma unroll
        for (int ai = 0; ai < 2; ++ai)
#pragma unroll
            for (int m = 0; m < 4; ++m) { bf16_t* rowp = O + (size_t)(row0 + ai * HALF + m * 16) * ldc + col0;
                const f32x4 g0 = acc[ai][0][m][0], g1 = acc[ai][0][m][1], u0 = acc[ai][1][m][0], u1 = acc[ai][1][m][1];
                u32x4 w;
                w.x = silu_pk_bf16(g0[0], g0[1], u0[0], u0[1]); w.y = silu_pk_bf16(g0[2], g0[3], u0[2], u0[3]);
                w.z = silu_pk_bf16(g1[0], g1[1], u1[0], u1[1]); w.w = silu_pk_bf16(g1[2], g1[3], u1[2], u1[3]);
                *(u32x4*)rowp = w; }
    }
};
struct EpiQKV {
    static constexpr bool PERM = true, AFTER_DRAIN = false;
    bf16_t* O; size_t stride; const float* rope;
    __device__ __forceinline__ void operator()(const f32x4 (&acc)[2][2][4][2], const Unit& u, int wr, int wc, int fr, int fq) const {
        const int t = u.pn >> 1; const int colt = (u.pn & 1) * BM;
        bf16_t* base = O + (size_t)t * stride;
        const int row0 = u.pm * BM + wr * 64 + fr; const int col0 = colt + wc * 32 + 8 * fq;
        const bool rot = (t < 2) && ((wc & 1) == 0);
        const float sgn = (fq == 0) ? -1.f : 1.f;
        const float qsc = (t == 3) ? 0.18033688011112042f : 1.0f;
#pragma unroll
        for (int ai = 0; ai < 2; ++ai)
#pragma unroll
            for (int m = 0; m < 4; ++m) { const int row = row0 + ai * HALF + m * 16; bf16_t* rowp = base + (size_t)row * 512 + col0;
                f32x4 c0 = {1.f, 1.f, 1.f, 1.f}, c1 = c0, s0 = {0.f, 0.f, 0.f, 0.f}, s1 = s0;
                if (rot && fq < 2) { const f32x4* rp = (const f32x4*)(rope + (size_t)row * 16); c0 = rp[0]; c1 = rp[1]; s0 = rp[2] * sgn; s1 = rp[3] * sgn; }
#pragma unroll
                for (int bj = 0; bj < 2; ++bj) { f32x4 v0 = acc[ai][bj][m][0], v1 = acc[ai][bj][m][1];
                    if (rot) {
                        f32x4 p0, p1;
#pragma unroll
                        for (int j = 0; j < 4; ++j) { p0[j] = __shfl_xor(v0[j], 16); p1[j] = __shfl_xor(v1[j], 16); }
                        v0 = v0 * c0 + p0 * s0; v1 = v1 * c1 + p1 * s1;
                    }
                    v0 = v0 * qsc; v1 = v1 * qsc;
                    u32x4 w; w.x = cvt_pk_bf16(v0[0], v0[1]); w.y = cvt_pk_bf16(v0[2], v0[3]); w.z = cvt_pk_bf16(v1[0], v1[1]); w.w = cvt_pk_bf16(v1[2], v1[3]);
                    *(u32x4*)(rowp + bj * HALF) = w; } }
    }
};

template <class Epi, class Sched, bool ALIGN_EPI = false, bool SP2 = false>
__device__ __forceinline__ void gemm_phase(PG8_LAS unsigned char* lds, const Gemm g, const Sched& S, const Epi& E) {
    int tid_o = threadIdx.x; asm volatile("" : "+v"(tid_o));
    const int tid = tid_o, wid = __builtin_amdgcn_readfirstlane(tid >> 6), lane = tid & 63, wr = wid >> 2, wc = wid & 3, fr = lane & 15, fq = lane >> 4;
    const int K = g.K, nt = K / BK;
    unsigned voffA[2], voffB[2];
#pragma unroll
    for (int i = 0; i < 2; ++i) { int R, C; stage_rc(tid * 16 + i * 8192, R, C); const int Rb = Epi::PERM ? ((R & ~31) + perm32(R & 31)) : R;
        voffA[i] = (unsigned)(R * K + C) * 2u; voffB[i] = (unsigned)(Rb * K + C) * 2u; }
    const size_t kstep = (size_t)(BK * 2);
    const size_t hstep = (size_t)HALF * K * 2;
    const size_t tstep = 2 * hstep;
    const unsigned ldsw = (unsigned)wid * 1024u;
    const int aoff = lds_byte(wr * 64 + fr, fq * 8), boff = lds_byte(wc * 32 + fr, fq * 8);
#define PG8_SA(b, h) (((b) * 2 + (h)) * HTB)
#define PG8_SB(b, h) ((4 + (b) * 2 + (h)) * HTB)
#define PG8_STAGE(bufoff, gbase, voff) do { _Pragma("unroll") for (int _i = 0; _i < 2; ++_i) \
        __builtin_amdgcn_global_load_lds((const unsigned*)((const char*)(gbase) + (voff)[_i]), (PG8_LAS unsigned*)(lds + (bufoff) + ldsw + _i * 8192), 16, 0, 0); } while (0)
#define PG8_LDA(dst, b, h) do { _Pragma("unroll") for (int m = 0; m < 4; ++m) _Pragma("unroll") for (int k = 0; k < 2; ++k) dst[m][k] = *(const PG8_LAS bf16x8*)(lds + PG8_SA(b, h) + aoff + m * 2048 + k * 1024); } while (0)
#define PG8_LDB(dst, b, h) do { _Pragma("unroll") for (int n = 0; n < 2; ++n) _Pragma("unroll") for (int k = 0; k < 2; ++k) dst[n][k] = *(const PG8_LAS bf16x8*)(lds + PG8_SB(b, h) + boff + n * 2048 + k * 1024); } while (0)
#define PG8_MMA(ai, bj, At, Bt) do { __builtin_amdgcn_s_setprio(1); _Pragma("unroll") for (int m = 0; m < 4; ++m) _Pragma("unroll") for (int n = 0; n < 2; ++n) _Pragma("unroll") for (int k = 0; k < 2; ++k) \
        acc[ai][bj][m][n] = __builtin_amdgcn_mfma_f32_16x16x32_bf16(Bt[n][k], At[m][k], acc[ai][bj][m][n], 0, 0, 0); __builtin_amdgcn_s_setprio(0); } while (0)
#define PG8_WAIT_V(n) asm volatile("s_waitcnt vmcnt(" #n ")" ::: "memory")
#define PG8_WAIT_L(n) asm volatile("s_waitcnt lgkmcnt(" #n ")" ::: "memory")
#define PG8_BAR __builtin_amdgcn_s_barrier()
#define PG8_SCHED __builtin_amdgcn_sched_barrier(0)
    Unit cur, nxt; int ui = 0;
    if (!S.next(0, cur)) return;
    f32x4 acc[2][2][4][2];
#pragma unroll
    for (int a = 0; a < 2; ++a)
#pragma unroll
        for (int b = 0; b < 2; ++b)
#pragma unroll
            for (int m = 0; m < 4; ++m)
#pragma unroll
                for (int n = 0; n < 2; ++n) acc[a][b][m][n] = (f32x4){0.f, 0.f, 0.f, 0.f};
    bf16x8 At[4][2], B0[2][2], B1[2][2];
    const char* cA = (const char*)g.A + (size_t)cur.pm * tstep; const char* cB = (const char*)g.Bt + (size_t)cur.pn * tstep;
    S.a_ready(cur);
    if constexpr (SP2) {
        PG8_STAGE(PG8_SB(0, 0), cB, voffB); PG8_STAGE(PG8_SB(0, 1), cB + hstep, voffB); PG8_STAGE(PG8_SA(0, 0), cA, voffA); PG8_STAGE(PG8_SA(0, 1), cA + hstep, voffA);
        if (wr == 1) PG8_BAR;
        PG8_WAIT_V(2); PG8_BAR;
        PG8_STAGE(PG8_SB(1, 0), cB + kstep, voffB); PG8_STAGE(PG8_SA(1, 0), cA + kstep, voffA); PG8_STAGE(PG8_SB(1, 1), cB + hstep + kstep, voffB);
        PG8_WAIT_V(6); PG8_BAR;
    } else {
        PG8_STAGE(PG8_SB(0, 0), cB, voffB); PG8_STAGE(PG8_SA(0, 0), cA, voffA); PG8_STAGE(PG8_SB(0, 1), cB + hstep, voffB); PG8_STAGE(PG8_SA(0, 1), cA + hstep, voffA);
        if (wr == 1) PG8_BAR;
        PG8_WAIT_V(4); PG8_BAR;
        PG8_STAGE(PG8_SB(1, 0), cB + kstep, voffB); PG8_STAGE(PG8_SA(1, 0), cA + kstep, voffA); PG8_STAGE(PG8_SB(1, 1), cB + hstep + kstep, voffB);
        PG8_WAIT_V(6); PG8_BAR;
    }
    for (;;) {
        const bool has_next = S.next(ui + 1, nxt);
        const char* nA = has_next ? (const char*)g.A + (size_t)nxt.pm * tstep : cA; const char* nB = has_next ? (const char*)g.Bt + (size_t)nxt.pn * tstep : cB;
        for (int t = 0; t < nt; t += 2) {
            const bool last = (t == nt - 2);
            const char* a1 = cA + (size_t)(t + 1) * kstep;
            const char* a2 = last ? nA : cA + (size_t)(t + 2) * kstep; const char* b2 = last ? nB : cB + (size_t)(t + 2) * kstep;
            const char* a3 = a2 + kstep; const char* b3 = b2 + kstep;
            if (last && has_next) S.a_ready(nxt);
            if constexpr (SP2) {
            PG8_LDB(B0, 0, 0); PG8_LDB(B1, 0, 1); PG8_SCHED; PG8_LDA(At, 0, 0); PG8_STAGE(PG8_SA(1, 1), a1 + hstep, voffA);
            PG8_WAIT_V(8); PG8_WAIT_L(0); PG8_BAR; PG8_MMA(0, 0, At, B0); PG8_MMA(0, 1, At, B1); PG8_BAR; PG8_SCHED;
            PG8_LDA(At, 0, 1); PG8_STAGE(PG8_SB(0, 0), b2, voffB); PG8_STAGE(PG8_SB(0, 1), b2 + hstep, voffB); PG8_STAGE(PG8_SA(0, 0), a2, voffA);
            PG8_WAIT_V(8); PG8_WAIT_L(0); PG8_BAR; PG8_MMA(1, 0, At, B0); PG8_MMA(1, 1, At, B1); PG8_BAR; PG8_SCHED;
            PG8_LDB(B0, 1, 0); PG8_LDB(B1, 1, 1); PG8_SCHED; PG8_LDA(At, 1, 0); PG8_STAGE(PG8_SA(0, 1), a2 + hstep, voffA);
            PG8_WAIT_V(8); PG8_WAIT_L(0); PG8_BAR; PG8_MMA(0, 0, At, B0); PG8_MMA(0, 1, At, B1); PG8_BAR; PG8_SCHED;
            PG8_LDA(At, 1, 1); PG8_STAGE(PG8_SB(1, 0), b3, voffB); PG8_STAGE(PG8_SB(1, 1), b3 + hstep, voffB); PG8_STAGE(PG8_SA(1, 0), a3, voffA);
            PG8_WAIT_V(8); PG8_WAIT_L(0); PG8_BAR; PG8_MMA(1, 0, At, B0); PG8_MMA(1, 1, At, B1); PG8_BAR; PG8_SCHED;
            } else {
            PG8_LDB(B0, 0, 0); PG8_SCHED; PG8_LDA(At, 0, 0); PG8_STAGE(PG8_SA(1, 1), a1 + hstep, voffA);
            PG8_WAIT_L(8); PG8_BAR; PG8_WAIT_L(0); PG8_MMA(0, 0, At, B0); PG8_BAR; PG8_SCHED;
            PG8_LDB(B1, 0, 1); PG8_STAGE(PG8_SB(0, 0), b2, voffB);
            PG8_BAR; PG8_WAIT_L(0); PG8_MMA(0, 1, At, B1); PG8_BAR;
            PG8_LDA(At, 0, 1); PG8_STAGE(PG8_SA(0, 0), a2, voffA);
            PG8_BAR; PG8_WAIT_L(0); PG8_MMA(1, 0, At, B0); PG8_BAR; PG8_SCHED;
            PG8_STAGE(PG8_SB(0, 1), b2 + hstep, voffB);
            PG8_WAIT_V(6); PG8_BAR; PG8_MMA(1, 1, At, B1); PG8_BAR;
            PG8_LDB(B0, 1, 0); PG8_SCHED; PG8_LDA(At, 1, 0); PG8_STAGE(PG8_SA(0, 1), a2 + hstep, voffA);
            PG8_WAIT_L(8); PG8_BAR; PG8_WAIT_L(0); PG8_MMA(0, 0, At, B0); PG8_BAR; PG8_SCHED;
            PG8_LDB(B1, 1, 1); PG8_STAGE(PG8_SB(1, 0), b3, voffB);
            PG8_BAR; PG8_WAIT_L(0); PG8_MMA(0, 1, At, B1); PG8_BAR;
            PG8_LDA(At, 1, 1); PG8_STAGE(PG8_SA(1, 0), a3, voffA);
            PG8_BAR; PG8_WAIT_L(0); PG8_MMA(1, 0, At, B0); PG8_BAR; PG8_SCHED;
            PG8_STAGE(PG8_SB(1, 1), b3 + hstep, voffB);
            PG8_WAIT_V(6); PG8_BAR; PG8_MMA(1, 1, At, B1); PG8_BAR;
            }
        }
        if constexpr (ALIGN_EPI) { if (wr == 0) PG8_BAR; }
        if constexpr (!Epi::AFTER_DRAIN) { E(acc, cur, wr, wc, fr, fq); S.done(cur); }
        if (!has_next) break;
#pragma unroll
        for (int a = 0; a < 2; ++a)
#pragma unroll
            for (int b = 0; b < 2; ++b)
#pragma unroll
                for (int m = 0; m < 4; ++m)
#pragma unroll
                    for (int n = 0; n < 2; ++n) acc[a][b][m][n] = (f32x4){0.f, 0.f, 0.f, 0.f};
        cur = nxt; cA = nA; cB = nB; ++ui;
        if constexpr (ALIGN_EPI) { if (wr == 1) PG8_BAR; }
    }
    PG8_WAIT_V(0);
    if constexpr (!ALIGN_EPI) { if (wr == 0) PG8_BAR; }
    PG8_BAR;
    if constexpr (Epi::AFTER_DRAIN) { E.fused(acc, cur, wr, wc, fr, fq, lds, wid, lane); S.done(cur); }
#undef PG8_SA
#undef PG8_SB
#undef PG8_STAGE
#undef PG8_LDA
#undef PG8_LDB
#undef PG8_MMA
#undef PG8_WAIT_V
#undef PG8_WAIT_L
#undef PG8_BAR
#undef PG8_SCHED
}
}
#include <hip/hip_bf16.h>
#include <cmath>
namespace attn_body {
using bf16=__hip_bfloat16;
using bf16x8=__attribute__((ext_vector_type(8)))short;
using s16x4=__attribute__((ext_vector_type(4)))short;
using f32x16=__attribute__((ext_vector_type(16)))float;
using u32x4=__attribute__((ext_vector_type(4)))unsigned;
using f32x4_t=__attribute__((ext_vector_type(4)))float;
constexpr int BATCH=32,NHEAD=8,SEQ=2048,D=64,DM=512;
constexpr int NW=8,QBLK=32,QB=QBLK*NW,KVBLK=64,NQB=SEQ/QB;
constexpr int ATTN_PITCH=DM, ATTN_UNIT_ROWS=QB;
__device__ __forceinline__ int crow(int r,int hi){return (r&3)+8*(r>>2)+4*hi;}
#define SBAR() __builtin_amdgcn_sched_barrier(0)
__device__ __forceinline__ void cmask(f32x16&p0,f32x16&p1,int jb,int qrel,int hi){
  const float NEG=-INFINITY; int lim=qrel-64*jb-4*hi; asm volatile("":"+v"(lim));
  #pragma unroll
  for(int r=0;r<16;++r){const int c=(r&3)+8*(r>>2); if(c>lim)p0[r]=NEG; if(c+32>lim)p1[r]=NEG;}
}

constexpr int NSLOT=3, SLOTB=8192;
constexpr int LDS_K=0, LDS_V=NSLOT*SLOTB, LDS_WS=2*NSLOT*SLOTB, LDS_OST=LDS_WS+NW*64*4, LDS_KB=LDS_OST+NW*4096, LDS_BYTES=LDS_KB+SEQ*4;
constexpr float C2=0.125f*1.4426950408889634f;
__device__ __forceinline__ void glds16(const void*gsrc,unsigned lds_dst){unsigned keep;
  asm volatile("s_mov_b32 %0, m0\n\ts_mov_b32 m0, %2\n\ts_nop 0\n\tglobal_load_lds_dwordx4 %1, off\n\ts_mov_b32 m0, %0":"=&s"(keep):"v"(gsrc),"s"(lds_dst):"memory");}
__device__ __forceinline__ float max3f(float a,float b,float c){float r;asm("v_max3_f32 %0, %1, %2, %3":"=v"(r):"v"(a),"v"(b),"v"(c));return r;}
__device__ __forceinline__ float max2f(float a,float b){float r;asm("v_max_f32_e32 %0, %1, %2":"=v"(r):"v"(a),"v"(b));return r;}
__device__ __forceinline__ float fadd_s(float a,float b){float r;asm("v_add_f32_e32 %0, %1, %2":"=v"(r):"v"(a),"v"(b));return r;}
__device__ __forceinline__ float fsub_s(float a,float b){float r;asm("v_sub_f32_e32 %0, %1, %2":"=v"(r):"v"(a),"v"(b));return r;}
typedef float f32x2_t __attribute__((ext_vector_type(2))); typedef __bf16 bf16x2_t __attribute__((ext_vector_type(2)));
__device__ __forceinline__ unsigned cvtpk_s(float lo,float hi){f32x2_t v={lo,hi};bf16x2_t b=__builtin_convertvector(v,bf16x2_t);return __builtin_bit_cast(unsigned,b);}
#define WAIT_BAR(N) asm volatile("s_waitcnt vmcnt(" #N ") lgkmcnt(0)\n\ts_barrier":::"memory")

__device__ __forceinline__ void qkt(f32x16&p0,f32x16&p1,const char*Kslot,const bf16x8*qr,const f32x16&c0,const f32x16&c1,int r32,int hi){
  const char*kb=Kslot+hi*1024+r32*16;
  #pragma unroll
  for(int d0=0;d0<4;++d0){
    const bf16x8 b0=*reinterpret_cast<const bf16x8*>(kb+d0*2048);
    const bf16x8 b1=*reinterpret_cast<const bf16x8*>(kb+d0*2048+512);
    if(d0==0){p0=__builtin_amdgcn_mfma_f32_32x32x16_bf16(b0,qr[0],c0,0,0,0);p1=__builtin_amdgcn_mfma_f32_32x32x16_bf16(b1,qr[0],c1,0,0,0);}
    else{p0=__builtin_amdgcn_mfma_f32_32x32x16_bf16(b0,qr[d0],p0,0,0,0);p1=__builtin_amdgcn_mfma_f32_32x32x16_bf16(b1,qr[d0],p1,0,0,0);}}
}
typedef __attribute__((address_space(3))) const char* lds_cptr;
typedef short v4i16_t __attribute__((ext_vector_type(4)));
__device__ __forceinline__ void kload8(bf16x8*kf,lds_cptr kp){
  kf[0]=*(const __attribute__((address_space(3))) bf16x8*)(kp);      kf[1]=*(const __attribute__((address_space(3))) bf16x8*)(kp+512);
  kf[2]=*(const __attribute__((address_space(3))) bf16x8*)(kp+2048); kf[3]=*(const __attribute__((address_space(3))) bf16x8*)(kp+2560);
  kf[4]=*(const __attribute__((address_space(3))) bf16x8*)(kp+4096); kf[5]=*(const __attribute__((address_space(3))) bf16x8*)(kp+4608);
  kf[6]=*(const __attribute__((address_space(3))) bf16x8*)(kp+6144); kf[7]=*(const __attribute__((address_space(3))) bf16x8*)(kp+6656);
}
__device__ __forceinline__ void kload2(bf16x8*kf,lds_cptr kp,int j){ kf[2*j]=*(const __attribute__((address_space(3))) bf16x8*)(kp+j*2048); kf[2*j+1]=*(const __attribute__((address_space(3))) bf16x8*)(kp+j*2048+512); }
__device__ __forceinline__ s16x4 vtr(lds_cptr p){ return __builtin_bit_cast(s16x4,__builtin_amdgcn_ds_read_tr16_b64_v4i16((__attribute__((address_space(3))) v4i16_t*)p)); }
__device__ __forceinline__ float rowmax(const f32x16&p0,const f32x16&p1){
  float a=max3f(p0[0],p0[1],p1[0]),b=max3f(p0[2],p0[3],p1[1]);a=max3f(a,p1[2],p1[3]);
  #pragma unroll
  for(int r=4;r<16;r+=4){a=max3f(a,p0[r],p0[r+1]);b=max3f(b,p0[r+2],p0[r+3]);a=max3f(a,p1[r],p1[r+1]);b=max3f(b,p1[r+2],p1[r+3]);}
  const float m=max2f(a,b);
  auto rr=__builtin_amdgcn_permlane32_swap(__float_as_uint(m),__float_as_uint(m),false,false);
  return max2f(__uint_as_float(rr[0]),__uint_as_float(rr[1]));
}
__device__ __forceinline__ void pv(f32x16*o,int vb,bf16x8 pa0,bf16x8 pa1,bf16x8 pa2,bf16x8 pa3){
  #pragma unroll
  for(int d0=0;d0<2;++d0){s16x4 lo[4],hi[4];
    #pragma unroll
    for(int ks=0;ks<4;++ks){
      asm volatile("ds_read_b64_tr_b16 %0,%1 offset:%c2":"=&v"(lo[ks]):"v"(vb),"i"(d0*4096+ks*1024):"memory");
      asm volatile("ds_read_b64_tr_b16 %0,%1 offset:%c2":"=&v"(hi[ks]):"v"(vb),"i"(d0*4096+ks*1024+512):"memory");}
    asm volatile("s_waitcnt lgkmcnt(0)":::"memory");SBAR();
    #define PK(k) (bf16x8){lo[k][0],lo[k][1],lo[k][2],lo[k][3],hi[k][0],hi[k][1],hi[k][2],hi[k][3]}
    o[d0]=__builtin_amdgcn_mfma_f32_32x32x16_bf16(pa0,PK(0),o[d0],0,0,0);
    o[d0]=__builtin_amdgcn_mfma_f32_32x32x16_bf16(pa1,PK(1),o[d0],0,0,0);
    o[d0]=__builtin_amdgcn_mfma_f32_32x32x16_bf16(pa2,PK(2),o[d0],0,0,0);
    o[d0]=__builtin_amdgcn_mfma_f32_32x32x16_bf16(pa3,PK(3),o[d0],0,0,0);
    #undef PK
  }
}

#ifndef ATTN_STORE16
#define ATTN_STORE16(p,v) (*(u32x4*)(p)=(v))
#endif
template<int THRL> __device__ __forceinline__ void attn_unit(int b,int h,int qb,const bf16*Q,const bf16*__restrict__ K,const bf16*__restrict__ V,bf16*O,char*shm){
  int tid_o=threadIdx.x; asm volatile("":"+v"(tid_o));
  const int tid=tid_o,lane=tid&63,r32=lane&31,hi=lane>>5; const int wid=__builtin_amdgcn_readfirstlane(tid>>6);
  const long rowbase=(long)b*SEQ; const int q0=qb*QB;
  const bf16*Qw=Q+(rowbase+q0+wid*QBLK)*DM+h*D;
  const bf16*Kh=K+rowbase*DM+h*D,*Vh=V+rowbase*DM+h*D;
  const unsigned lds0=(unsigned)(uintptr_t)shm;
  float*wsf=(float*)(shm+LDS_WS)+wid*64;
  const bf16*ksrc=Kh+(long)(lane+q0+QB-KVBLK)*DM+wid*8;
  const bf16*vsrc=Vh+(long)(16*(wid&3)+(lane>>2)+q0+QB-KVBLK)*DM+(wid>>2)*32+(lane&3)*8;
  const unsigned kdst=lds0+LDS_K+wid*1024, vdst=lds0+LDS_V+wid*1024;
  #define DMA_K(t,slot) glds16(ksrc-(long)(t)*KVBLK*DM,(unsigned)__builtin_amdgcn_readfirstlane(kdst+(slot)))
  #define DMA_V(t,slot) glds16(vsrc-(long)(t)*KVBLK*DM,(unsigned)__builtin_amdgcn_readfirstlane(vdst+(slot)))
  const int vb0=(int)(lds0+LDS_V)+((lane>>4)&1)*32+(lane&3)*8+(4*hi+((lane&15)>>2))*64;
  const char*Kbase=shm+LDS_K; bf16x8 kf[8];
  const lds_cptr shm3=(lds_cptr)shm; const lds_cptr kp0=shm3+LDS_K+hi*1024+r32*16; const lds_cptr vp0=shm3+LDS_V+((lane>>4)&1)*32+(lane&3)*8+(4*hi+((lane&15)>>2))*64;
  const int NT=(q0+QB)/KVBLK;
  DMA_K(0,0);DMA_V(0,0);DMA_K(1,SLOTB);
  bf16x8 qr[4];
  #pragma unroll
  for(int d0=0;d0<4;++d0)qr[d0]=*reinterpret_cast<const bf16x8*>(&Qw[(long)r32*DM+d0*16+hi*8]);
  float mhat=0.f,l_reg=0.f;f32x16 o[2];o[0]=f32x16{};o[1]=f32x16{};  typedef __attribute__((address_space(3))) const f32x4_t* lds_f4ptr; const lds_f4ptr kbl4=(lds_f4ptr)(shm3+LDS_KB)+hi+(q0+QB-KVBLK)/4;
  #define NB0(t,N0) do{ _Pragma("unroll") for(int g_=0;g_<4;++g_){ const f32x4_t v0_=kbl4[2*g_-16*(t)]; \
      _Pragma("unroll") for(int j_=0;j_<4;++j_){ N0[4*g_+j_]=v0_[j_]-mhat; } } }while(0)
  #define NB1(t,N1) do{ _Pragma("unroll") for(int g_=0;g_<4;++g_){ const f32x4_t v1_=kbl4[8+2*g_-16*(t)]; \
      _Pragma("unroll") for(int j_=0;j_<4;++j_){ N1[4*g_+j_]=v1_[j_]-mhat; } } }while(0)
  const int qrel=wid*QBLK+r32;
  #define CMASK(P0,P1,t) do{int jb_=3-(t); if(jb_>=0)cmask(P0,P1,jb_,qrel,hi);}while(0)
  bool resc=false;
  #define START(P0,P1) do{ const float rm=rowmax(P0,P1); resc=false; \
    { const float dl=(rm==-INFINITY)?0.f:rm; mhat=fadd_s(mhat,dl); \
      _Pragma("unroll") for(int r=0;r<16;++r){P0[r]=fsub_s(P0[r],dl);P1[r]=fsub_s(P1[r],dl);} \
      } \
    _Pragma("unroll") for(int r=0;r<16;++r)P0[r]=__builtin_amdgcn_exp2f(P0[r]); }while(0)
  #define RESC() do{ if(resc){ asm volatile("s_waitcnt lgkmcnt(0)":::"memory"); \
      _Pragma("unroll") for(int d_=0;d_<2;++d_) _Pragma("unroll") for(int r=0;r<16;++r)o[d_][r]*=wsf[crow(r,hi)]; } }while(0)
  f32x16 pA0,pA1,pB0,pB1;
  int sl_prev=0,sl_cur=0,sl_next=SLOTB;
  #define ROT() do{sl_prev=sl_cur;sl_cur=sl_next;sl_next=(sl_next==(NSLOT-1)*SLOTB)?0:sl_next+SLOTB;}while(0)
  DMA_K(2,2*SLOTB);
  WAIT_BAR(3);
  { f32x16 nb0_,nb1_; NB0(0,nb0_); NB1(0,nb1_); qkt(pA0,pA1,Kbase,qr,nb0_,nb1_,r32,hi); }asm volatile("s_nop 15\n\ts_nop 7":"+v"(pA0),"+v"(pA1));CMASK(pA0,pA1,0);
  START(pA0,pA1);
  f32x16 nbc; NB0(1,nbc);
  _Pragma("unroll") for(int r=0;r<16;++r)pA1[r]=__builtin_amdgcn_exp2f(pA1[r]);
  WAIT_BAR(0);
  DMA_K(3,0);DMA_V(1,SLOTB);
  ROT();
  kload8(kf,kp0+sl_cur);
  WAIT_BAR(2);
  s16x4 vlo[8],vhi[8]; u32x4 pw0,pw1,pw2,pw3;
  #define PKW(P,B) cvtpk_s(P[B],P[B+1])
  #define PAF(k) __builtin_bit_cast(bf16x8,pw##k)
  #define VFR(i) (bf16x8){vlo[i][0],vlo[i][1],vlo[i][2],vlo[i][3],vhi[i][0],vhi[i][1],vhi[i][2],vhi[i][3]}
  #define PIN(x) asm volatile("":"+v"(x))
  #define MX3(a,b,c) __builtin_fmaxf(__builtin_fmaxf((a),(b)),(c))
  #define GAPA(MF,A0,A1,A2,A3,W0,W1,PW) do{ MF; sacc+=A0; sacc+=A1; sacc+=A2; sacc+=A3; PIN(sacc); W0; W1; PIN(PW); SBAR(); }while(0)
  #define EX(v) __builtin_amdgcn_exp2f(v)
  #define GAPB(MF,X,B) do{ MF; X[B]=EX(X[B]); X[B+1]=EX(X[B+1]); X[B+2]=EX(X[B+2]); X[B+3]=EX(X[B+3]); PIN(X); SBAR(); }while(0)
  #define VRD(i) do{ vlo[i]=vtr(vp_+(((i)>>2)*4096+((i)&3)*1024)); vhi[i]=vtr(vp_+(((i)>>2)*4096+((i)&3)*1024+512)); }while(0)
  #define KRD(G,j) do{ if(G){ kload2(kf,kp0+sl_next,j); SBAR(); } }while(0)
  #define STEP(C0,C1,P0,P1,t,GK,GV,GL) do{ SBAR(); f32x16 nb1_; \
    const lds_cptr vp_=vp0+sl_prev; \
    VRD(0); SBAR(); float sacc=(P0[0]+P0[1]); \
    GAPA(C0=__builtin_amdgcn_mfma_f32_32x32x16_bf16(kf[0],qr[0],nbc,0,0,0), P0[2],P0[3],P0[4],P0[5],     pw0[0]=PKW(P0,0), pw0[1]=PKW(P0,2), pw0); \
    NB1(t,nb1_); VRD(4); SBAR(); GAPA(C1=__builtin_amdgcn_mfma_f32_32x32x16_bf16(kf[1],qr[0],nb1_,0,0,0), P0[6],P0[7],P0[8],P0[9],     pw0[2]=PKW(P0,4), pw0[3]=PKW(P0,6), pw0); \
    VRD(1); SBAR(); GAPA(C0=__builtin_amdgcn_mfma_f32_32x32x16_bf16(kf[2],qr[1],C0,0,0,0),   P0[10],P0[11],P0[12],P0[13], pw1[0]=PKW(P0,8), pw1[1]=PKW(P0,10), pw1); \
    VRD(5); SBAR(); GAPA(C1=__builtin_amdgcn_mfma_f32_32x32x16_bf16(kf[3],qr[1],C1,0,0,0),   P0[14],P0[15],P1[0],P1[1],   pw1[2]=PKW(P0,12),pw1[3]=PKW(P0,14), pw1); \
    VRD(2); SBAR(); GAPA(C0=__builtin_amdgcn_mfma_f32_32x32x16_bf16(kf[4],qr[2],C0,0,0,0),   P1[2],P1[3],P1[4],P1[5],     pw2[0]=PKW(P1,0), pw2[1]=PKW(P1,2), pw2); \
    VRD(6); SBAR(); GAPA(C1=__builtin_amdgcn_mfma_f32_32x32x16_bf16(kf[5],qr[2],C1,0,0,0),   P1[6],P1[7],P1[8],P1[9],     pw2[2]=PKW(P1,4), pw2[3]=PKW(P1,6), pw2); \
    VRD(3); SBAR(); GAPA(C0=__builtin_amdgcn_mfma_f32_32x32x16_bf16(kf[6],qr[3],C0,0,0,0),   P1[10],P1[11],P1[12],P1[13], pw3[0]=PKW(P1,8), pw3[1]=PKW(P1,10), pw3); \
    VRD(7); SBAR(); GAPA(C1=__builtin_amdgcn_mfma_f32_32x32x16_bf16(kf[7],qr[3],C1,0,0,0),   P1[14],P1[15],0.f,0.f,       pw3[2]=PKW(P1,12),pw3[3]=PKW(P1,14), pw3); \
    l_reg+=sacc; \
    if(GK){DMA_K((t)+3,sl_cur);} if(GV){DMA_V((t)+1,sl_next);} \
    CMASK(C0,C1,t); \
    { float a=MX3(C0[0],C0[1],C1[0]),b=MX3(C0[2],C0[3],C1[1]); a=MX3(a,C1[2],C1[3]); \
      _Pragma("unroll") for(int r=4;r<16;r+=4){a=MX3(a,C0[r],C0[r+1]);b=MX3(b,C0[r+2],C0[r+3]);a=MX3(a,C1[r],C1[r+1]);b=MX3(b,C1[r+2],C1[r+3]);} \
      float rm=__builtin_fmaxf(a,b); { auto rr=__builtin_amdgcn_permlane32_swap(__float_as_uint(rm),__float_as_uint(rm),false,false); rm=__builtin_fmaxf(__uint_as_float(rr[0]),__uint_as_float(rr[1])); } \
      resc=false; \
      if(__builtin_expect(__any(rm>(float)THRL),0)){ const float dl=__builtin_fmaxf(rm,0.f); mhat+=dl; \
        _Pragma("unroll") for(int r=0;r<16;++r){C0[r]-=dl;C1[r]-=dl;} \
        const float f=__builtin_amdgcn_exp2f(-dl); l_reg*=f; if(hi==0)wsf[r32]=f; resc=true; } } \
    SBAR(); \
    GAPB(o[0]=__builtin_amdgcn_mfma_f32_32x32x16_bf16(PAF(0),VFR(0),o[0],0,0,0), C0,0); \
    GAPB(o[1]=__builtin_amdgcn_mfma_f32_32x32x16_bf16(PAF(0),VFR(4),o[1],0,0,0), C0,4); \
    KRD(GL,0); GAPB(o[0]=__builtin_amdgcn_mfma_f32_32x32x16_bf16(PAF(1),VFR(1),o[0],0,0,0), C0,8); \
    KRD(GL,1); GAPB(o[1]=__builtin_amdgcn_mfma_f32_32x32x16_bf16(PAF(1),VFR(5),o[1],0,0,0), C0,12); \
    KRD(GL,2); GAPB(o[0]=__builtin_amdgcn_mfma_f32_32x32x16_bf16(PAF(2),VFR(2),o[0],0,0,0), C1,0); \
    KRD(GL,3); GAPB(o[1]=__builtin_amdgcn_mfma_f32_32x32x16_bf16(PAF(2),VFR(6),o[1],0,0,0), C1,4); \
    GAPB(o[0]=__builtin_amdgcn_mfma_f32_32x32x16_bf16(PAF(3),VFR(3),o[0],0,0,0), C1,8); \
    GAPB(o[1]=__builtin_amdgcn_mfma_f32_32x32x16_bf16(PAF(3),VFR(7),o[1],0,0,0), C1,12); \
    if(GL){ NB0((t)+1,nbc); } \
    }while(0)
  int t=1;
  for(;t+5<NT;t+=2){
    STEP(pB0,pB1,pA0,pA1,t,true,true,true);     WAIT_BAR(2); RESC(); ROT();
    STEP(pA0,pA1,pB0,pB1,t+1,true,true,true);   WAIT_BAR(2); RESC(); ROT();
  }
  #undef CMASK
  #define CMASK(P0,P1,t) do{int jb_=3-(t); if(jb_>=0)cmask(P0,P1,jb_,qrel,hi);}while(0)
  #define ENDW(tt) do{ if((tt)+3<NT){WAIT_BAR(2);} else if((tt)+2<NT){WAIT_BAR(1);} else {WAIT_BAR(0);} }while(0)
  for(;t+1<NT;t+=2){
    STEP(pB0,pB1,pA0,pA1,t,(t+3<NT),(t+1<NT),(t+1<NT));       ENDW(t);   RESC(); ROT();
    STEP(pA0,pA1,pB0,pB1,t+1,(t+4<NT),(t+2<NT),(t+2<NT));     ENDW(t+1); RESC(); ROT();
  }
  STEP(pB0,pB1,pA0,pA1,NT-1,false,false,false); RESC();
  { float sacc=pB0[0]+pB0[1]; _Pragma("unroll") for(int r=2;r<16;++r)sacc+=pB0[r]; _Pragma("unroll") for(int r=0;r<16;++r)sacc+=pB1[r]; l_reg+=sacc;
    pw0=(u32x4){PKW(pB0,0),PKW(pB0,2),PKW(pB0,4),PKW(pB0,6)};pw1=(u32x4){PKW(pB0,8),PKW(pB0,10),PKW(pB0,12),PKW(pB0,14)};pw2=(u32x4){PKW(pB1,0),PKW(pB1,2),PKW(pB1,4),PKW(pB1,6)};pw3=(u32x4){PKW(pB1,8),PKW(pB1,10),PKW(pB1,12),PKW(pB1,14)};
    SBAR(); pv(o,vb0+sl_cur,PAF(0),PAF(1),PAF(2),PAF(3)); }
  #undef PKW
  #undef PAF
  #undef VFR
  #undef PIN
  #undef MX3
  #undef GAPA
  #undef GAPB
  #undef EX
  #undef VRD
  #undef KRD
  #undef STEP
  #undef ENDW
  {auto rr=__builtin_amdgcn_permlane32_swap(__float_as_uint(l_reg),__float_as_uint(l_reg),false,false);l_reg=__uint_as_float(rr[0])+__uint_as_float(rr[1]);}
  if(hi==0)wsf[32+r32]=l_reg;asm volatile("s_waitcnt lgkmcnt(0)":::"memory");
  float rli[16];
  #pragma unroll
  for(int r=0;r<16;++r)rli[r]=__builtin_amdgcn_rcpf(wsf[32+crow(r,hi)]);
  bf16*Ow=O+(rowbase+q0+wid*QBLK)*DM+h*D;
  { bf16*stg=(bf16*)(shm+LDS_OST)+wid*2048;
    #pragma unroll
    for(int r=0;r<16;++r){const int orow=crow(r,hi);
      #pragma unroll
      for(int d0=0;d0<2;++d0)stg[orow*64+d0*32+r32]=__float2bfloat16(o[d0][r]*rli[r]);}
    asm volatile("s_waitcnt lgkmcnt(0)":::"memory");
    #pragma unroll
    for(int i=0;i<4;++i){const int row=i*8+(lane>>3),ch=lane&7; const u32x4 v=*(const u32x4*)(stg+row*64+ch*8); ATTN_STORE16(Ow+(long)row*DM+ch*8,v);} }
  asm volatile("s_waitcnt lgkmcnt(0)\n\ts_barrier":::"memory");
  #undef DMA_K
  #undef DMA_V
  #undef NB0
  #undef NB1
  #undef CMASK
  #undef START
  #undef RESC
  #undef ROT
}
constexpr int ATTN_LDS_BYTES=LDS_BYTES;
#undef SBAR
#undef WAIT_BAR
}

#define LAS __attribute__((address_space(3)))
typedef unsigned short bf16_t;
typedef short bf16x8 __attribute__((ext_vector_type(8)));
typedef short s16x4 __attribute__((ext_vector_type(4)));
typedef float f32x4 __attribute__((ext_vector_type(4)));
typedef float f32x16 __attribute__((ext_vector_type(16)));
typedef unsigned u32x4 __attribute__((ext_vector_type(4)));
typedef unsigned u32x2 __attribute__((ext_vector_type(2)));

constexpr int DM = 1024, NBATCH = 32, SEQ = 2048, T = NBATCH * SEQ, DFF = 2752, DFFP = 2816, INCOLS = 3080, NMODC = 9 * DM;
constexpr int NWAVES = 8, NTHR = 512;
constexpr float EPS = 1e-6f, LOG2E = 1.4426950408889634f;
constexpr size_t MiB = 1u << 20;
constexpr size_t WS_WGU1 = 0, WS_WD1 = 11 * MiB, WS_WGU2 = 17 * MiB, WS_WD2 = 28 * MiB, WS_WIN = 34 * MiB, WS_WOUT = 40 * MiB, WS_MOD = 42 * MiB,
                 WS_ROPE = 44 * MiB, WS_FL = 48 * MiB, WS_KB = 50 * MiB, WS_LSE = 52 * MiB, WS_WF = 58 * MiB, WS_BAR = 59 * MiB,
                 WS_H = 64 * MiB, WS_Y = 192 * MiB, WS_BIG = 320 * MiB, WS_OA = 704 * MiB, WS_OB = 896 * MiB, WS_END = 960 * MiB;
constexpr size_t QKV_STRIDE = (size_t)T * 512;
constexpr int LDS_BYTES = 151552;

__device__ __forceinline__ float wave_sum(float v) {
#pragma unroll
    for (int o = 1; o < 64; o <<= 1) v += __shfl_xor(v, o);
    return v;
}
__device__ __forceinline__ unsigned pk2(float lo, float hi) { return pg8::cvt_pk_bf16(lo, hi); }
__device__ __forceinline__ float bf_lo(unsigned u) { return __uint_as_float(u << 16); }
__device__ __forceinline__ float bf_hi(unsigned u) { return __uint_as_float(u & 0xffff0000u); }
#define LDS_WAIT() asm volatile("s_waitcnt lgkmcnt(0)" ::: "memory")

__device__ __forceinline__ int opaque_tid() { int t = threadIdx.x; asm volatile("" : "+v"(t)); return t; }
__device__ __forceinline__ void tr_item(const float* __restrict__ W, int ldn, int k0, int n0, bf16_t* WT, int Kd, int drow0, LAS float* scr, int lane) {
#pragma unroll 8
    for (int i = 0; i < 32; ++i) { const int kk = 2 * i + (lane >> 5); scr[kk * 33 + (lane & 31)] = W[(size_t)(k0 + kk) * ldn + n0 + (lane & 31)]; }
    LDS_WAIT();
    const int c = lane & 7;
#pragma unroll
    for (int j = 0; j < 4; ++j) { const int n = (lane >> 3) + 8 * j; const LAS float* s = scr + (8 * c) * 33 + n;
        u32x4 o; o.x = pk2(s[0 * 33], s[1 * 33]); o.y = pk2(s[2 * 33], s[3 * 33]); o.z = pk2(s[4 * 33], s[5 * 33]); o.w = pk2(s[6 * 33], s[7 * 33]);
        *(u32x4*)(WT + (size_t)(drow0 + n) * Kd + k0 + 8 * c) = o; }
    LDS_WAIT();
}

struct Args { const float* in[22]; float* out; unsigned char* ws; };

__device__ __forceinline__ void p0_phase(const Args& a, LAS unsigned char* lds, int tid, int lane, int wave) {
    unsigned char* ws = a.ws;
    const int G = gridDim.x;
    {
        LAS float* sc = (LAS float*)lds;
        const float* c = a.in[1]; const float* wada = a.in[3]; const float* bada = a.in[4]; float* MOD = (float*)(ws + WS_MOD);
        for (int it = blockIdx.x; it < NMODC / 64; it += G) {
            __syncthreads();
            for (int e = tid; e < NBATCH * DM; e += NTHR) { const float v = c[e]; sc[e] = v / (1.0f + __expf(-v)); }
            __syncthreads();
            const int j = it * 64 + lane; const int kb = wave * 128;
            float acc[32];
#pragma unroll
            for (int b = 0; b < 32; ++b) acc[b] = 0.f;
            for (int k4 = 0; k4 < 128; k4 += 4) {
                const float w0 = wada[(size_t)(kb + k4 + 0) * NMODC + j], w1 = wada[(size_t)(kb + k4 + 1) * NMODC + j],
                            w2 = wada[(size_t)(kb + k4 + 2) * NMODC + j], w3 = wada[(size_t)(kb + k4 + 3) * NMODC + j];
#pragma unroll
                for (int b = 0; b < 32; ++b) { const f32x4 s = *(const LAS f32x4*)(sc + b * DM + kb + k4); acc[b] += s[0] * w0 + s[1] * w1 + s[2] * w2 + s[3] * w3; }
            }
            __syncthreads();
            LAS float* P = (LAS float*)lds;
#pragma unroll
            for (int b = 0; b < 32; ++b) P[(wave * 32 + b) * 64 + lane] = acc[b];
            __syncthreads();
            for (int o = tid; o < 32 * 64; o += NTHR) { const int b = o >> 6, col = o & 63; float s = 0.f;
#pragma unroll
                for (int w = 0; w < 8; ++w) s += P[(w * 32 + b) * 64 + col];
                MOD[(size_t)b * NMODC + it * 64 + col] = s + bada[it * 64 + col]; }
        }
        __syncthreads();
    }
    {
        LAS float* scr = (LAS float*)(lds + wave * 16384);
        const int gw = blockIdx.x * NWAVES + wave, NGW = G * NWAVES;
        constexpr int I_G = 16 * 86, I_D = 43 * 32, I_IN = 16 * 96, I_O = 16 * 32;
        constexpr int NITEMS = 2 * (2 * I_G + I_D) + I_IN + I_O;
        for (int it = gw; it < NITEMS; it += NGW) {
            int r = it; bool done = false;
#pragma unroll
            for (int f = 0; f < 2; ++f) {
                if (done) break;
                const float* Wg = a.in[f ? 19 : 7]; const float* Wu = a.in[f ? 20 : 8]; const float* Wd = a.in[f ? 21 : 9];
                bf16_t* WGU = (bf16_t*)(ws + (f ? WS_WGU2 : WS_WGU1)); bf16_t* WD = (bf16_t*)(ws + (f ? WS_WD2 : WS_WD1));
                if (r < 2 * I_G) { const int up = r >= I_G; const int q = up ? r - I_G : r; const int kb = q / 86, nb = q % 86, n0 = 32 * nb;
                    tr_item(up ? Wu : Wg, DFF, 64 * kb, n0, WGU, DM, 256 * (n0 >> 7) + (n0 & 127) + (up ? 128 : 0), scr, lane); done = true; continue; }
                r -= 2 * I_G;
                if (r < I_D) { const int kb = r / 32, nb = r % 32; tr_item(Wd, DM, 64 * kb, 32 * nb, WD, DFFP, 32 * nb, scr, lane); done = true; continue; }
                r -= I_D;
            }
            if (done) continue;
            if (r < I_IN) { const int kb = r / 96, nb = r % 96; tr_item(a.in[12], INCOLS, 64 * kb, 32 * nb, (bf16_t*)(ws + WS_WIN), DM, 32 * nb, scr, lane); continue; }
            r -= I_IN;
            { const int kb = r / 32, nb = r % 32; tr_item(a.in[16], DM, 64 * kb, 32 * nb, (bf16_t*)(ws + WS_WOUT), DM, 32 * nb, scr, lane); }
        }
    }
    {
        const int gt = blockIdx.x * NTHR + tid, NT = G * NTHR;
        for (int e = gt; e < 2 * 128 * 128; e += NT) { const int f = e >> 14, q = e & 16383, rr = q >> 7, ch = q & 127;
            bf16_t* WGU = (bf16_t*)(ws + (f ? WS_WGU2 : WS_WGU1)); const int row = 21 * 256 + (rr < 64 ? 64 + rr : 128 + rr);
            *(u32x4*)(WGU + (size_t)row * DM + ch * 8) = (u32x4){0u, 0u, 0u, 0u}; }
        for (int e = gt; e < 2 * 1024 * 8; e += NT) { const int f = e >> 13, q = e & 8191, row = q >> 3, ch = q & 7;
            bf16_t* WD = (bf16_t*)(ws + (f ? WS_WD2 : WS_WD1)); *(u32x4*)(WD + (size_t)row * DFFP + DFF + ch * 8) = (u32x4){0u, 0u, 0u, 0u}; }
        float* WF = (float*)(ws + WS_WF);
        for (int e = gt; e < 8 * DM; e += NT) { const int j = e >> 10, k = e & 1023; WF[e] = a.in[12][(size_t)k * INCOLS + 3072 + j]; }
        float* ROPE = (float*)(ws + WS_ROPE); const int* pos = (const int*)a.in[2];
        for (int e = gt; e < T * 8; e += NT) { const int row = e >> 3, i = e & 7; const float inv = exp2f(-(float)i * 0.125f * 18.931568569324174f);
            const float ang = (float)pos[row] * inv; ROPE[(size_t)row * 16 + i] = cosf(ang); ROPE[(size_t)row * 16 + 8 + i] = sinf(ang); }
    }
}

typedef _Float16 f16x4 __attribute__((ext_vector_type(4)));
template <bool HAS_Y, bool HAS_H, bool HAS_FL, bool XIN16, bool XOUT16>
__device__ __forceinline__ void rowpass(const float* xin, float* xout, const bf16_t* Y, bf16_t* H, float* FL, const float* g_post, const float* g_pre,
                                        const float* MOD, int gi, float gscale, int sci, int shi, LAS const float* wfl, int lane, int wave, int b0, int nbat) {
    constexpr int R = 2;
    const int gw = blockIdx.x * NWAVES + wave, NGW = gridDim.x * NWAVES;
    const int WPB = (NGW / nbat) > 0 ? (NGW / nbat) : 1; const int wb = b0 + gw / WPB, wj = gw % WPB;
    int cur_b = -1;
    f32x4 A[4], Bv[4], Cv[4];
#pragma unroll
    for (int j = 0; j < 4; ++j) { A[j] = (f32x4){0.f, 0.f, 0.f, 0.f}; Bv[j] = A[j]; Cv[j] = A[j]; }
    for (int lr = wj * R; lr < SEQ && wb < b0 + nbat; lr += WPB * R) {
        const int row0 = wb * SEQ + lr;
        const int b = wb;
        if (b != cur_b) { cur_b = b;
#pragma unroll
            for (int j = 0; j < 4; ++j) { const int c = 4 * lane + 256 * j;
                if (HAS_Y) A[j] = *(const f32x4*)(MOD + (size_t)b * NMODC + gi * DM + c) * *(const f32x4*)(g_post + c) * gscale;
                if (HAS_H) { Bv[j] = *(const f32x4*)(g_pre + c) * (*(const f32x4*)(MOD + (size_t)b * NMODC + sci * DM + c) + 1.0f); Cv[j] = *(const f32x4*)(MOD + (size_t)b * NMODC + shi * DM + c); } } }
        f32x4 x[R][4]; u32x2 yw[R][4];
#pragma unroll
        for (int q = 0; q < R; ++q)
#pragma unroll
            for (int j = 0; j < 4; ++j) {
                if (XIN16) { const f16x4 hv = __builtin_nontemporal_load((const f16x4*)((const char*)xin + (size_t)(row0 + q) * 4096 + 2048 + (4 * lane + 256 * j) * 2)); x[q][j] = __builtin_convertvector(hv, f32x4); }
                else x[q][j] = __builtin_nontemporal_load((const f32x4*)(xin + (size_t)(row0 + q) * DM + 4 * lane + 256 * j));
                if (HAS_Y) yw[q][j] = __builtin_nontemporal_load((const u32x2*)(Y + (size_t)(row0 + q) * DM + 4 * lane + 256 * j)); }
        if (HAS_Y) {
            float ss[R];
#pragma unroll
            for (int q = 0; q < R; ++q) { ss[q] = 0.f;
#pragma unroll
                for (int j = 0; j < 4; ++j) { const float y0 = bf_lo(yw[q][j].x), y1 = bf_hi(yw[q][j].x), y2 = bf_lo(yw[q][j].y), y3 = bf_hi(yw[q][j].y); ss[q] += (y0 * y0 + y1 * y1) + (y2 * y2 + y3 * y3); } }
#pragma unroll
            for (int o = 1; o < 64; o <<= 1)
#pragma unroll
                for (int q = 0; q < R; ++q) ss[q] += __shfl_xor(ss[q], o);
#pragma unroll
            for (int q = 0; q < R; ++q) { const float rstd = 1.0f / sqrtf(ss[q] * (1.0f / DM) + EPS);
#pragma unroll
                for (int j = 0; j < 4; ++j) { const f32x4 y = {bf_lo(yw[q][j].x), bf_hi(yw[q][j].x), bf_lo(yw[q][j].y), bf_hi(yw[q][j].y)};
                    x[q][j] = x[q][j] + A[j] * (y * rstd);
                    if (XOUT16) __builtin_nontemporal_store(__builtin_convertvector(x[q][j], f16x4), (f16x4*)((char*)xout + (size_t)(row0 + q) * 4096 + 2048 + (4 * lane + 256 * j) * 2));
                    else __builtin_nontemporal_store(x[q][j], (f32x4*)(xout + (size_t)(row0 + q) * DM + 4 * lane + 256 * j)); } }
        }
        if (HAS_H) {
            float ss[R];
#pragma unroll
            for (int q = 0; q < R; ++q) { ss[q] = 0.f;
#pragma unroll
                for (int j = 0; j < 4; ++j) ss[q] += (x[q][j][0] * x[q][j][0] + x[q][j][1] * x[q][j][1]) + (x[q][j][2] * x[q][j][2] + x[q][j][3] * x[q][j][3]); }
#pragma unroll
            for (int o = 1; o < 64; o <<= 1)
#pragma unroll
                for (int q = 0; q < R; ++q) ss[q] += __shfl_xor(ss[q], o);
#pragma unroll
            for (int q = 0; q < R; ++q) { const float rstd = 1.0f / sqrtf(ss[q] * (1.0f / DM) + EPS);
                f32x4 h[4];
#pragma unroll
                for (int j = 0; j < 4; ++j) { h[j] = (x[q][j] * rstd) * Bv[j] + Cv[j];
                    u32x2 w; w.x = pk2(h[j][0], h[j][1]); w.y = pk2(h[j][2], h[j][3]); *(u32x2*)(H + (size_t)(row0 + q) * DM + 4 * lane + 256 * j) = w; }
                if (HAS_FL) {
                    float myv = 0.f;
#pragma unroll
                    for (int f = 0; f < 8; ++f) { float d = 0.f;
#pragma unroll
                        for (int j = 0; j < 4; ++j) { const f32x4 wv = *(const LAS f32x4*)(wfl + f * DM + 4 * lane + 256 * j); d += (h[j][0] * wv[0] + h[j][1] * wv[1]) + (h[j][2] * wv[2] + h[j][3] * wv[3]); }
                        d = wave_sum(d); if (lane == f) myv = d; }
                    if (lane < 8) FL[(size_t)(row0 + q) * 8 + lane] = myv;
                }
            }
        }
    }
}

namespace att {
constexpr int KP = 144;
constexpr float C2 = 0.125f * 1.4426950408889634f;
#define MFMA32(a, b, c) __builtin_amdgcn_mfma_f32_32x32x16_bf16((a), (b), (c), 0, 0, 0)
__device__ __forceinline__ s16x4 vtr(LAS const unsigned char* p) { return __builtin_bit_cast(s16x4, __builtin_amdgcn_ds_read_tr16_b64_v4i16((LAS s16x4*)p)); }
__device__ __forceinline__ bf16x8 pack8(const f32x16& x, int s) {
    u32x4 p; p.x = pk2(x[8 * s + 0], x[8 * s + 1]); p.y = pk2(x[8 * s + 2], x[8 * s + 3]); p.z = pk2(x[8 * s + 4], x[8 * s + 5]); p.w = pk2(x[8 * s + 6], x[8 * s + 7]);
    return __builtin_bit_cast(bf16x8, p);
}
template <int NKB, bool M0, bool M1, bool BIAS>
__device__ __forceinline__ void step(LAS const unsigned char* kbuf, LAS const unsigned char* vbuf, LAS const float* kbias, const bf16x8 (&qf)[4], f32x16 (&o)[2], float& m, float& l,
                                     int lo0, int hi0, int lo1, int hi1, int r, int h, int lane) {
    f32x16 s[NKB];
#pragma unroll
    for (int kb = 0; kb < NKB; ++kb) {
#pragma unroll
        for (int i = 0; i < 16; ++i) s[kb][i] = 0.f;
#pragma unroll
        for (int ss = 0; ss < 4; ++ss) { const bf16x8 kf = *(const LAS bf16x8*)(kbuf + (32 * kb + r) * KP + 32 * ss + 16 * h); s[kb] = MFMA32(kf, qf[ss], s[kb]); }
    }
    float mx = -INFINITY;
#pragma unroll
    for (int kb = 0; kb < NKB; ++kb) {
        const bool MK = kb == 0 ? M0 : M1; const int lo = (kb == 0 ? lo0 : lo1) - 4 * h, hi = (kb == 0 ? hi0 : hi1) - 4 * h; const unsigned span = (unsigned)(hi - lo);
#pragma unroll
        for (int g = 0; g < 4; ++g) {
            f32x4 bv = {0.f, 0.f, 0.f, 0.f};
            if (BIAS) bv = *(const LAS f32x4*)(kbias + 32 * kb + 8 * g + 4 * h);
#pragma unroll
            for (int j = 0; j < 4; ++j) { const int i = 4 * g + j; float v = s[kb][i] * C2 + bv[j];
                if (MK) { const int c = j + 8 * g; v = ((unsigned)(c - lo) <= span && hi >= lo) ? v : -INFINITY; }
                s[kb][i] = v; mx = fmaxf(mx, v); }
        }
    }
    mx = fmaxf(mx, __shfl_xor(mx, 32));
    const float mn = fmaxf(m, mx); const float alpha = __builtin_amdgcn_exp2f(m - mn); m = mn;
    float ps = 0.f;
#pragma unroll
    for (int kb = 0; kb < NKB; ++kb)
#pragma unroll
        for (int i = 0; i < 16; ++i) { const float p = __builtin_amdgcn_exp2f(s[kb][i] - mn); s[kb][i] = p; ps += p; }
    l = l * alpha + ps;
#pragma unroll
    for (int i = 0; i < 16; ++i) { o[0][i] *= alpha; o[1][i] *= alpha; }
    const int q4 = (lane & 15) >> 2, p4 = lane & 3, blk = (lane >> 4) & 1;
    LAS const unsigned char* vb = vbuf + (4 * h + q4) * KP + 32 * blk + 8 * p4;
#pragma unroll
    for (int kb = 0; kb < NKB; ++kb)
#pragma unroll
        for (int s2 = 0; s2 < 2; ++s2) { const bf16x8 pf = pack8(s[kb], s2);
#pragma unroll
            for (int db = 0; db < 2; ++db) { const s16x4 a0 = vtr(vb + (32 * kb + 16 * s2) * KP + 64 * db), a1 = vtr(vb + (32 * kb + 16 * s2 + 8) * KP + 64 * db);
                const bf16x8 vf = __builtin_shufflevector(a0, a1, 0, 1, 2, 3, 4, 5, 6, 7); o[db] = MFMA32(vf, pf, o[db]); } }
}
__device__ __forceinline__ float finish(f32x16 (&o)[2], float l, bf16_t* orow, int h) {
    const float lt = l + __shfl_xor(l, 32); const float inv = 1.0f / lt;
#pragma unroll
    for (int db = 0; db < 2; ++db)
#pragma unroll
        for (int g = 0; g < 4; ++g) { u32x2 w; w.x = pk2(o[db][4 * g + 0] * inv, o[db][4 * g + 1] * inv); w.y = pk2(o[db][4 * g + 2] * inv, o[db][4 * g + 3] * inv);
            *(u32x2*)(orow + 32 * db + 8 * g + 4 * h) = w; }
    return lt;
}

__device__ __forceinline__ void a_phase(const bf16_t* Q, const bf16_t* K, const bf16_t* V, bf16_t* OA, float* LSE, LAS unsigned char* lds, int tid, int lane, int wave, int b0, int nbat) {
    const int r = lane & 31, h = lane >> 5, half = wave >> 2, w4 = wave & 3, t256 = tid & 255;
    LAS unsigned char* kbase = lds + half * (2 * 256 * KP); LAS unsigned char* vbase = kbase + 256 * KP;
    for (int it = blockIdx.x; it < nbat * 8 * 24; it += gridDim.x) {
        const int su = b0 * 8 * 48 + 2 * it + half; const int bh = su / 48, u = su % 48, p = u >> 4, v = u & 15, b = bh >> 3, hd = bh & 7;
        const int d = (p == 0) ? 1 : (p == 1 ? 4 : 16); const int cls = (p == 0) ? 0 : (p == 1 ? (v >> 2) : v); const int n = (p == 0) ? v : (p == 1 ? (v & 3) : 0);
        __syncthreads();
#pragma unroll
        for (int bt = 0; bt < 2; ++bt) {
            u32x4 kr[4], vr[4];
#pragma unroll
            for (int i = 0; i < 4; ++i) { const int idx = t256 + 256 * (4 * bt + i); const int j = idx >> 3, ch = idx & 7; const int mk = 128 * n - 128 + j;
                if (mk >= 0) { const size_t row = (size_t)b * SEQ + mk * d + cls; kr[i] = *(const u32x4*)(K + row * 512 + hd * 64 + ch * 8); vr[i] = *(const u32x4*)(V + row * 512 + hd * 64 + ch * 8); }
                else { kr[i] = (u32x4){0u, 0u, 0u, 0u}; vr[i] = kr[i]; } }
#pragma unroll
            for (int i = 0; i < 4; ++i) { const int idx = t256 + 256 * (4 * bt + i); const int j = idx >> 3, ch = idx & 7;
                *(LAS u32x4*)(kbase + j * KP + ch * 16) = kr[i]; *(LAS u32x4*)(vbase + j * KP + ch * 16) = vr[i]; }
        }
        const int mq = 128 * n + 32 * w4 + r; const size_t qrow = (size_t)b * SEQ + mq * d + cls;
        bf16x8 qf[4];
#pragma unroll
        for (int ss = 0; ss < 4; ++ss) qf[ss] = *(const bf16x8*)(Q + qrow * 512 + hd * 64 + 16 * ss + 8 * h);
        __syncthreads();
        f32x16 o[2];
#pragma unroll
        for (int i = 0; i < 16; ++i) { o[0][i] = 0.f; o[1][i] = 0.f; }
        float m = -1e30f, l = 0.f;
        const int jlo = (n == 0) ? max(32 * w4 + r, 128) : 32 * w4 + r, jhi = 128 + 32 * w4 + r;
        LAS const unsigned char* kw = kbase + 32 * w4 * KP; LAS const unsigned char* vw = vbase + 32 * w4 * KP;
        if (n > 0) {
            step<2, true, false, false>(kw, vw, nullptr, qf, o, m, l, r, 31, 0, 31, r, h, lane);
            step<2, false, false, false>(kw + 64 * KP, vw + 64 * KP, nullptr, qf, o, m, l, 0, 0, 0, 0, r, h, lane);
        } else {
            if (w4 + 1 >= 4) step<2, true, true, false>(kw, vw, nullptr, qf, o, m, l, jlo - 32 * w4, jhi - 32 * w4, jlo - 32 * (w4 + 1), jhi - 32 * (w4 + 1), r, h, lane);
            if (w4 + 3 >= 4) step<2, true, true, false>(kw + 64 * KP, vw + 64 * KP, nullptr, qf, o, m, l, jlo - 32 * (w4 + 2), jhi - 32 * (w4 + 2), jlo - 32 * (w4 + 3), jhi - 32 * (w4 + 3), r, h, lane);
        }
        step<1, true, false, false>(kw + 128 * KP, vw + 128 * KP, nullptr, qf, o, m, l, jlo - 32 * (w4 + 4), jhi - 32 * (w4 + 4), 0, 0, r, h, lane);
        const float lt = finish(o, l, OA + ((size_t)p * T + qrow) * 512 + hd * 64, h);
        if (h == 0) LSE[((size_t)p * T + qrow) * 8 + hd] = m + __log2f(lt);
    }
    __syncthreads();
}
}


__device__ __forceinline__ void b_phase2(const bf16_t* Q, const bf16_t* K, const bf16_t* V, const float* KBIAS, bf16_t* O, unsigned char* shm, int tid, int b0, int nbat) {
    for (int it = blockIdx.x; it < nbat * 8 * 2; it += gridDim.x) {
        const int bh = b0 * 8 + (it >> 1), set = it & 1;
        const int t2 = opaque_tid();
        const f32x4 v = *(const f32x4*)(KBIAS + (size_t)bh * SEQ + 4 * t2);
        *(LAS f32x4*)((LAS unsigned char*)shm + attn_body::LDS_KB + 16 * t2) = v;
        __syncthreads();
        for (int k = 0; k < 4; ++k) { const int qb = (k & 1) ? (2 * (k >> 1) + set) : (7 - 2 * (k >> 1) - set);
            attn_body::attn_unit<8>(bh >> 3, bh & 7, qb, (const attn_body::bf16*)Q, (const attn_body::bf16*)K, (const attn_body::bf16*)V, (attn_body::bf16*)O, (char*)shm); }
    }
    __syncthreads();
}

__device__ __forceinline__ void merge_pass(const bf16_t* OA, const float* LSE, const bf16_t* OB, const float* g_a, const float* g_b, bf16_t* MG, int lane, int wave, int r0, int nrows) {
    constexpr int R = 4;
    const int gw = blockIdx.x * NWAVES + wave, NGW = gridDim.x * NWAVES;
    f32x4 ga0 = *(const f32x4*)(g_a + 8 * lane), ga1 = *(const f32x4*)(g_a + 8 * lane + 4), gb0 = *(const f32x4*)(g_b + 8 * lane), gb1 = *(const f32x4*)(g_b + 8 * lane + 4);
    const int hd = lane >> 3;
    for (int rowb = r0 + gw * R; rowb < r0 + nrows; rowb += NGW * R) {
        float ls[R][3]; u32x4 w[R][3], wb[R];
#pragma unroll
        for (int q = 0; q < R; ++q) { const int row = rowb + q;
#pragma unroll
            for (int p = 0; p < 3; ++p) { ls[q][p] = LSE[((size_t)p * T + row) * 8 + hd]; w[q][p] = *(const u32x4*)(OA + ((size_t)p * T + row) * 512 + 8 * lane); }
            wb[q] = *(const u32x4*)(OB + (size_t)row * 512 + 8 * lane); }
        float va[R][8], vb[R][8], sa[R], sb[R];
#pragma unroll
        for (int q = 0; q < R; ++q) {
            const float mx = fmaxf(ls[q][0], fmaxf(ls[q][1], ls[q][2]));
            float e[3]; e[0] = __builtin_amdgcn_exp2f(ls[q][0] - mx); e[1] = __builtin_amdgcn_exp2f(ls[q][1] - mx); e[2] = __builtin_amdgcn_exp2f(ls[q][2] - mx);
            const float inv = 1.0f / (e[0] + e[1] + e[2]);
#pragma unroll
            for (int k = 0; k < 4; ++k) {
                float lo = 0.f, hi = 0.f;
#pragma unroll
                for (int p = 0; p < 3; ++p) { lo += e[p] * bf_lo(w[q][p][k]); hi += e[p] * bf_hi(w[q][p][k]); }
                va[q][2 * k] = lo * inv; va[q][2 * k + 1] = hi * inv; vb[q][2 * k] = bf_lo(wb[q][k]); vb[q][2 * k + 1] = bf_hi(wb[q][k]);
            }
            sa[q] = 0.f; sb[q] = 0.f;
#pragma unroll
            for (int k = 0; k < 8; ++k) { sa[q] += va[q][k] * va[q][k]; sb[q] += vb[q][k] * vb[q][k]; }
        }
#pragma unroll
        for (int o = 1; o < 64; o <<= 1)
#pragma unroll
            for (int q = 0; q < R; ++q) { sa[q] += __shfl_xor(sa[q], o); sb[q] += __shfl_xor(sb[q], o); }
#pragma unroll
        for (int q = 0; q < R; ++q) { const int row = rowb + q;
            const float ra = 1.0f / sqrtf(sa[q] * (1.0f / 512.0f) + EPS), rb = 1.0f / sqrtf(sb[q] * (1.0f / 512.0f) + EPS);
            u32x4 oa, ob;
            oa.x = pk2(va[q][0] * ra * ga0[0], va[q][1] * ra * ga0[1]); oa.y = pk2(va[q][2] * ra * ga0[2], va[q][3] * ra * ga0[3]); oa.z = pk2(va[q][4] * ra * ga1[0], va[q][5] * ra * ga1[1]); oa.w = pk2(va[q][6] * ra * ga1[2], va[q][7] * ra * ga1[3]);
            ob.x = pk2(vb[q][0] * rb * gb0[0], vb[q][1] * rb * gb0[1]); ob.y = pk2(vb[q][2] * rb * gb0[2], vb[q][3] * rb * gb0[3]); ob.z = pk2(vb[q][4] * rb * gb1[0], vb[q][5] * rb * gb1[1]); ob.w = pk2(vb[q][6] * rb * gb1[2], vb[q][7] * rb * gb1[3]);
            *(u32x4*)(MG + (size_t)row * DM + 8 * lane) = oa; *(u32x4*)(MG + (size_t)row * DM + 512 + 8 * lane) = ob; }
    }
}

__device__ __forceinline__ void cumsum_phase(const float* FL, const float* bforget, float* KBIAS, LAS unsigned char* lds, int tid, int lane, int wave, int b0, int nbat) {
    LAS float* wt = (LAS float*)lds;
    for (int it = b0 * 8 + blockIdx.x; it < (b0 + nbat) * 8; it += gridDim.x) {
        const int b = it >> 3, hd = it & 7; const float bf = bforget[hd];
        float v[4];
#pragma unroll
        for (int i = 0; i < 4; ++i) { const float z = FL[((size_t)b * SEQ + 4 * tid + i) * 8 + hd] + bf; v[i] = fminf(z, 0.f) - log1pf(__expf(-fabsf(z))); }
        v[1] += v[0]; v[2] += v[1]; v[3] += v[2];
        float sc = v[3];
#pragma unroll
        for (int o = 1; o < 64; o <<= 1) { const float t = __shfl_up(sc, o); if (lane >= o) sc += t; }
        __syncthreads();
        if (lane == 63) wt[wave] = sc;
        __syncthreads();
        float off = sc - v[3];
        for (int w = 0; w < wave; ++w) off += wt[w];
        f32x4 o4 = {-(off + v[0]) * LOG2E, -(off + v[1]) * LOG2E, -(off + v[2]) * LOG2E, -(off + v[3]) * LOG2E};
        *(f32x4*)(KBIAS + (size_t)it * SEQ + 4 * tid) = o4;
    }
    __syncthreads();
}

#define XB_TMO      128
#define XB_XCNT(j)  (256  + 64 * (j))
#define XB_XSUB(j)  (1280 + 64 * (j))
#define XB_XGEN(j)  (2304 + 64 * (j))
#define XB_TOP      3328
#define XB_TOPGEN   3392
#define XCD_BAR_WORDS 3456
#define XB_SPIN_CAP (1u << 18)

__device__ __forceinline__ unsigned xb_ld(unsigned* p)              { return __hip_atomic_load(p, __ATOMIC_RELAXED, __HIP_MEMORY_SCOPE_AGENT); }
__device__ __forceinline__ unsigned xb_add(unsigned* p, unsigned v) { return __hip_atomic_fetch_add(p, v, __ATOMIC_RELAXED, __HIP_MEMORY_SCOPE_AGENT); }
__device__ __forceinline__ unsigned xb_xcc_id() { return (unsigned)__builtin_amdgcn_s_getreg((3 << 11) | 20) & 0xFu; }
#define XB_SPIN(cond, bar) do { unsigned _sp = 0; while (cond) { __builtin_amdgcn_s_sleep(1); \
    if ((++_sp & 255u) == 0u) { if (xb_ld(&(bar)[XB_TMO])) break; if (_sp > XB_SPIN_CAP) { atomicAdd(&(bar)[XB_TMO], 1u); break; } } } } while (0)

struct XcdBarrier {
    unsigned* bar; unsigned x;
    volatile LAS unsigned* st;
};

__device__ __forceinline__ XcdBarrier xcd_barrier_post(unsigned* bar, volatile LAS unsigned* st) {
    XcdBarrier b; b.bar = bar; b.x = xb_xcc_id(); b.st = st;
    if (threadIdx.x == 0) (void)xb_add(&bar[XB_XCNT(b.x)], 1u);
    return b;
}
__device__ __forceinline__ void xcd_barrier_complete(unsigned* bar, unsigned x, unsigned& nloc, unsigned& nx) {
    const unsigned G = gridDim.x * gridDim.y * gridDim.z;
    unsigned sum, cnt, mine, sp = 0u;
    for (;;) {
        sum = 0u; cnt = 0u; mine = 0u;
#pragma unroll
        for (unsigned j = 0; j < 16; ++j) { const unsigned c = xb_ld(&bar[XB_XCNT(j)]); sum += c; cnt += (c > 0u) ? 1u : 0u; mine = (j == x) ? c : mine; }
        if (sum == G) break;
        __builtin_amdgcn_s_sleep(1);
        if ((++sp & 255u) == 0u) { if (xb_ld(&bar[XB_TMO])) break; if (sp > XB_SPIN_CAP) { atomicAdd(&bar[XB_TMO], 1u); break; } }
    }
    nloc = mine > 0u ? mine : 1u; nx = cnt > 0u ? cnt : 1u;
}

__device__ __forceinline__ void xcd_barrier(const XcdBarrier& b) {
    asm volatile("s_waitcnt vmcnt(0)" ::: "memory");
    __syncthreads();
    if (threadIdx.x == 0) {
        unsigned* bar = b.bar;
        __builtin_amdgcn_s_waitcnt(0);
        unsigned nloc = b.st[0], nx = b.st[1];
        if (nloc == 0u) { xcd_barrier_complete(bar, b.x, nloc, nx); b.st[0] = nloc; b.st[1] = nx; }
        const unsigned old = xb_add(&bar[XB_XSUB(b.x)], 1u);
        const unsigned gen = old / nloc;
        if (old + 1u == (gen + 1u) * nloc) {
            __builtin_amdgcn_fence(__ATOMIC_RELEASE, "agent");
            asm volatile("s_waitcnt vmcnt(0)" ::: "memory");
            const unsigned og = xb_add(&bar[XB_TOP], 1u);
            const unsigned tg = og / nx;
            if (og + 1u == (tg + 1u) * nx) xb_add(&bar[XB_TOPGEN], 1u);
            else XB_SPIN(xb_ld(&bar[XB_TOPGEN]) == tg, bar);
            __builtin_amdgcn_fence(__ATOMIC_ACQUIRE, "agent");
            xb_add(&bar[XB_XGEN(b.x)], 1u);
            asm volatile("s_waitcnt vmcnt(0)" ::: "memory");
        } else {
            XB_SPIN(xb_ld(&bar[XB_XGEN(b.x)]) == gen, bar);
            __builtin_amdgcn_fence(__ATOMIC_ACQUIRE, "agent");
            asm volatile("s_waitcnt vmcnt(0)" ::: "memory");
        }
    }
    __syncthreads();
}

__global__ void __launch_bounds__(NTHR, 2) mega_fwd(Args a) {
    extern __shared__ __attribute__((aligned(16))) unsigned char lds_raw[];
    LAS unsigned char* lds = (LAS unsigned char*)lds_raw;
    cg::grid_group grid = cg::this_grid();
#define IDS() const int tid = opaque_tid(), lane = tid & 63, wave = __builtin_amdgcn_readfirstlane(tid >> 6); (void)lane; (void)wave
    unsigned char* ws = a.ws;
    bf16_t* H = (bf16_t*)(ws + WS_H); bf16_t* Y = (bf16_t*)(ws + WS_Y); bf16_t* HID = (bf16_t*)(ws + WS_BIG); bf16_t* QKV = (bf16_t*)(ws + WS_BIG);
    bf16_t* OA = (bf16_t*)(ws + WS_OA); bf16_t* OB = (bf16_t*)(ws + WS_OB);
    float* MOD = (float*)(ws + WS_MOD); float* FL = (float*)(ws + WS_FL); float* KBIAS = (float*)(ws + WS_KB); float* LSE = (float*)(ws + WS_LSE);
    const float* x = a.in[0]; float* out = a.out;
    const int G = gridDim.x, cb = blockIdx.x;

    volatile LAS unsigned* bst = (volatile LAS unsigned*)(lds + 151040);
    unsigned* barw = (unsigned*)(ws + WS_BAR);
    { IDS();
    if (tid < 2) bst[tid] = 0u;
    if (blockIdx.x == 0) for (int i = tid; i < XCD_BAR_WORDS; i += NTHR) barw[i] = 0u; }
    { IDS(); p0_phase(a, lds, tid, lane, wave); }
    grid.sync();
    const XcdBarrier bar = xcd_barrier_post(barw, bst);
    for (int st = 1; st <= 13; ++st) {
        const bool r0job = (st == 1 || st == 4 || st == 7 || st == 9 || st == 12);
        const bool r1job = (st == 2 || st == 5 || st == 8 || st == 10 || st == 13);
        const bool odd = (blockIdx.x & 1) != 0;
        const int first = r0job ? (odd ? 0 : 1) : (r1job ? (odd ? 1 : 0) : 0);
        for (int kk = 0; kk < 2; ++kk) {
            const int grp = kk == 0 ? first : 1 - first; const int ph = st - grp;
            if (ph < 1 || ph > 12) continue;
            const int b0 = grp * (NBATCH / 2); const size_t r0 = (size_t)grp * (T / 2); constexpr int NB2 = NBATCH / 2, M2 = T / 2;
            if (ph == 1) { IDS(); rowpass<false, true, false, false, false>(x, nullptr, nullptr, H, nullptr, nullptr, a.in[5], MOD, 0, 0.f, 1, 0, nullptr, lane, wave, b0, NB2); }
            else if (ph == 2 || ph == 10) { const bool f2 = ph == 10;
                pg8::Gemm g{H + r0 * DM, (const bf16_t*)(ws + (f2 ? WS_WGU2 : WS_WGU1)), M2, 2 * DFFP, DM}; pg8::StaticOrder S; S.init(M2, 2 * DFFP, G, cb); pg8::EpiSwiglu E{HID + r0 * DFFP, DFFP};
                pg8::gemm_phase<pg8::EpiSwiglu, pg8::StaticOrder, true, true>(lds, g, S, E); }
            else if (ph == 3 || ph == 8 || ph == 11) { const bool o = ph == 8;
                pg8::Gemm g{o ? H + r0 * DM : HID + r0 * DFFP, (const bf16_t*)(ws + (o ? WS_WOUT : (ph == 3 ? WS_WD1 : WS_WD2))), M2, DM, o ? DM : DFFP}; pg8::StaticOrder S; S.init(M2, DM, G, cb); pg8::EpiPlain E{Y + r0 * DM, DM};
                pg8::gemm_phase<pg8::EpiPlain, pg8::StaticOrder, true, true>(lds, g, S, E); }
            else if (ph == 4) { IDS(); LAS float* wfl = (LAS float*)lds; const float* WF = (const float*)(ws + WS_WF);
                for (int e = tid; e < 8 * DM; e += NTHR) wfl[e] = WF[e];
                __syncthreads();
                rowpass<true, true, true, false, true>(x, out, Y, H, FL, a.in[6], a.in[10], MOD, 2, 0.5f, 4, 3, wfl, lane, wave, b0, NB2);
                __syncthreads(); }
            else if (ph == 5) { { IDS(); cumsum_phase(FL, a.in[13], KBIAS, lds, tid, lane, wave, b0, NB2); }
                pg8::Gemm g{H + r0 * DM, (const bf16_t*)(ws + WS_WIN), M2, 3072, DM}; pg8::StaticOrder S; S.init(M2, 3072, G, cb); pg8::EpiQKV E{QKV + r0 * 512, QKV_STRIDE, (const float*)(ws + WS_ROPE) + r0 * 16};
                pg8::gemm_phase<pg8::EpiQKV, pg8::StaticOrder, true, true>(lds, g, S, E); }
            else if (ph == 6) { { IDS(); b_phase2(QKV + 3 * QKV_STRIDE, QKV + 4 * QKV_STRIDE, QKV + 5 * QKV_STRIDE, KBIAS, OB, lds_raw, tid, b0, NB2); }
                { IDS(); att::a_phase(QKV, QKV + QKV_STRIDE, QKV + 2 * QKV_STRIDE, OA, LSE, lds, tid, lane, wave, b0, NB2); } }
            else if (ph == 7) { IDS(); merge_pass(OA, LSE, OB, a.in[14], a.in[15], H, lane, wave, (int)r0, M2); }
            else if (ph == 9) { IDS(); rowpass<true, true, false, true, true>(out, out, Y, H, nullptr, a.in[11], a.in[17], MOD, 5, 1.0f, 7, 6, nullptr, lane, wave, b0, NB2); }
            else { IDS(); rowpass<true, false, false, true, false>(out, out, Y, nullptr, nullptr, a.in[18], nullptr, MOD, 8, 0.5f, 0, 0, nullptr, lane, wave, b0, NB2); }
        }
        if (st < 13) xcd_barrier(bar);
    }
}

extern "C" void kernel_launch(void* const* d_in, const int* in_sizes, int n_in, void* d_out, int out_size, void* d_ws, size_t ws_size, hipStream_t stream) {
    static int grid = 0;
    if (grid == 0) {
        if (n_in != 22 || in_sizes[0] != T * DM || out_size != T * DM || ws_size < WS_END) { fprintf(stderr, "kernel_launch: unexpected shapes (n_in %d, ws %zu)\n", n_in, ws_size); grid = -1; return; }
        int dev = 0, cus = 0, per_cu = 0;
        (void)hipGetDevice(&dev); (void)hipDeviceGetAttribute(&cus, hipDeviceAttributeMultiprocessorCount, dev);
        if (hipFuncSetAttribute((const void*)mega_fwd, hipFuncAttributeMaxDynamicSharedMemorySize, LDS_BYTES) != hipSuccess) { fprintf(stderr, "kernel_launch: hipFuncSetAttribute failed\n"); grid = -1; return; }
        if (hipOccupancyMaxActiveBlocksPerMultiprocessor(&per_cu, (const void*)mega_fwd, NTHR, LDS_BYTES) != hipSuccess || per_cu < 1) { fprintf(stderr, "kernel_launch: occupancy query says %d\n", per_cu); per_cu = 1; }
        (void)hipGetLastError();
        grid = cus;
    }
    if (grid < 0) return;
    Args a{};
    for (int i = 0; i < 22; ++i) a.in[i] = (const float*)d_in[i];
    a.out = (float*)d_out; a.ws = (unsigned char*)d_ws;
    void* args[] = {&a};
    hipError_t e = hipLaunchCooperativeKernel((const void*)mega_fwd, dim3(grid), dim3(NTHR), args, LDS_BYTES, stream);
    if (e != hipSuccess) fprintf(stderr, "kernel_launch: cooperative launch failed: %s (grid %d)\n", hipGetErrorString(e), grid);
}
```
